# Optimizing an MI355X kernel written in HIP

```python
import math
import jax, jax.numpy as jnp
from jax import lax
import numpy as np

D_MODEL = 1024
BATCH = 8
SEQ = 2048
DEPTH = 2

GRID_W = 64
CTX_LEN = 256
BLOCK = 128
WINDOW = 128
ROPE_BASE = 10000.0
EPS = 1e-6
HQ_A = 16
HKV_A = 2
HD_A = 64
GROUP_A = HQ_A // HKV_A
HQ_B = 8
HKV_B = 2
HD_B = 128
GROUP_B = HQ_B // HKV_B
N_EXPERTS = 32
TOP_K = 4
D_FF = D_MODEL
SWIGLU_LIMIT = 7.0
SWIGLU_ALPHA = 1.702
N_LAYERS_A = (DEPTH + 1) // 2
N_LAYERS_B = DEPTH // 2

kernel_name = "hybrid_dit_window_sink_gqa_qknorm_moe"


def rmsnorm(x, g):
    xf = x.astype(jnp.float32)
    y = xf * lax.rsqrt(jnp.mean(xf * xf, axis=-1, keepdims=True) + EPS)
    return (y * g.astype(jnp.float32)).astype(x.dtype)


def modulate(h, shift, scale):
    return h * (1 + scale) + shift


def axial_rope_tables(rows, head_dim):
    quarter = head_dim // 4
    inv_freq = jnp.float32(ROPE_BASE) ** (-jnp.arange(quarter, dtype=jnp.float32) / quarter)
    row_idx = jnp.repeat(jnp.arange(rows, dtype=jnp.float32), GRID_W)
    col_idx = jnp.tile(jnp.arange(GRID_W, dtype=jnp.float32), rows)
    ang_r = row_idx[:, None] * inv_freq[None, :]
    ang_c = col_idx[:, None] * inv_freq[None, :]
    return (jnp.cos(ang_r), jnp.sin(ang_r), jnp.cos(ang_c), jnp.sin(ang_c))


def _rotate(xp, cos, sin):
    x1, x2 = jnp.split(xp, 2, axis=-1)
    return jnp.concatenate([x1 * cos - x2 * sin, x2 * cos + x1 * sin], axis=-1)


def apply_axial_rope(x, tabs):
    cr, sr, cc, sc = tabs
    shape = (x.shape[1],) + (1,) * (x.ndim - 3) + (-1,)
    cast = lambda t: t.reshape(shape).astype(x.dtype)
    xr, xc = jnp.split(x, 2, axis=-1)
    return jnp.concatenate([_rotate(xr, cast(cr), cast(sr)), _rotate(xc, cast(cc), cast(sc))], axis=-1)


def split_qkv(h, w_qkv, hq, hkv, hd):
    b, n, _ = h.shape
    qkv = h @ w_qkv
    q, k, v = jnp.split(qkv, [hq * hd, (hq + hkv) * hd], axis=-1)
    return (q.reshape(b, n, hkv, hq // hkv, hd), k.reshape(b, n, hkv, hd), v.reshape(b, n, hkv, hd))


def ctx_self_attention(q, k, v, sink):
    scale = q.shape[-1] ** -0.5
    s = jnp.einsum('bqgrd,bkgd->bgrqk', q, k).astype(jnp.float32) * scale
    if sink is not None:
        sb = jnp.broadcast_to(sink.astype(jnp.float32)[None, :, :, None, None], s.shape[:-1] + (1,))
        p = jax.nn.softmax(jnp.concatenate([s, sb], axis=-1), axis=-1)[..., :-1]
    else:
        p = jax.nn.softmax(s, axis=-1)
    o = jnp.einsum('bgrqk,bkgd->bqgrd', p.astype(v.dtype), v)
    return o.reshape(o.shape[0], o.shape[1], -1)


def mixer_window_sink(h_lat, h_ctx, w_qkv, w_o, sink, rope_tabs, need_ctx):
    b, n, _ = h_lat.shape
    nb = n // BLOCK
    scale = HD_A ** -0.5
    q, k, v = split_qkv(h_lat, w_qkv, HQ_A, HKV_A, HD_A)
    qc, kc, vc = split_qkv(h_ctx, w_qkv, HQ_A, HKV_A, HD_A)
    q = apply_axial_rope(q, rope_tabs)
    k = apply_axial_rope(k, rope_tabs)
    sink_gr = sink.reshape(HKV_A, GROUP_A)

    qb = q.reshape(b, nb, BLOCK, HKV_A, GROUP_A, HD_A)
    pad = ((0, 0), (BLOCK, BLOCK), (0, 0), (0, 0))
    kp = jnp.pad(k, pad).reshape(b, nb + 2, BLOCK, HKV_A, HD_A)
    vp = jnp.pad(v, pad).reshape(b, nb + 2, BLOCK, HKV_A, HD_A)
    kw = jnp.concatenate([kp[:, :-2], kp[:, 1:-1], kp[:, 2:]], axis=2)
    vw = jnp.concatenate([vp[:, :-2], vp[:, 1:-1], vp[:, 2:]], axis=2)

    qpos = jnp.arange(n).reshape(nb, BLOCK)
    kpos = jnp.arange(nb)[:, None] * BLOCK - BLOCK + jnp.arange(3 * BLOCK)[None, :]
    mask = (jnp.abs(qpos[:, :, None] - kpos[:, None, :]) <= WINDOW) & (kpos[:, None, :] >= 0) & (kpos[:, None, :] < n)

    s_win = jnp.einsum('bnqgrd,bnkgd->bngrqk', qb, kw).astype(jnp.float32) * scale
    s_win = jnp.where(mask[None, :, None, None, :, :], s_win, jnp.float32(-1e30))
    s_ctx = jnp.einsum('bnqgrd,bcgd->bngrqc', qb, kc).astype(jnp.float32) * scale
    s_sink = jnp.broadcast_to(sink_gr.astype(jnp.float32)[None, None, :, :, None, None], s_win.shape[:-1] + (1,))
    p = jax.nn.softmax(jnp.concatenate([s_win, s_ctx, s_sink], axis=-1), axis=-1)
    p_win = p[..., :3 * BLOCK].astype(v.dtype)
    p_ctx = p[..., 3 * BLOCK:3 * BLOCK + kc.shape[1]].astype(v.dtype)
    o = jnp.einsum('bngrqk,bnkgd->bnqgrd', p_win, vw) + jnp.einsum('bngrqc,bcgd->bnqgrd', p_ctx, vc)
    o_lat = o.reshape(b, n, HQ_A * HD_A) @ w_o
    o_ctx = ctx_self_attention(qc, kc, vc, sink_gr) @ w_o if need_ctx else None
    return o_lat, o_ctx


def mixer_qknorm_gqa(h_lat, h_ctx, w_qkv, q_norm, k_norm, w_o, rope_tabs, need_ctx):
    b, n, _ = h_lat.shape
    nb = n // BLOCK
    scale = HD_B ** -0.5
    q, k, v = split_qkv(h_lat, w_qkv, HQ_B, HKV_B, HD_B)
    qc, kc, vc = split_qkv(h_ctx, w_qkv, HQ_B, HKV_B, HD_B)
    q, qc = rmsnorm(q, q_norm), rmsnorm(qc, q_norm)
    k, kc = rmsnorm(k, k_norm), rmsnorm(kc, k_norm)
    q = apply_axial_rope(q, rope_tabs)
    k = apply_axial_rope(k, rope_tabs)
    k_all = jnp.concatenate([k, kc], axis=1)
    v_all = jnp.concatenate([v, vc], axis=1)

    qb = q.reshape(b, nb, BLOCK, HKV_B, GROUP_B, HD_B).transpose(1, 0, 2, 3, 4, 5)

    def attend_block(q_blk):
        s = jnp.einsum('bqgrd,bkgd->bgrqk', q_blk, k_all).astype(jnp.float32) * scale
        p = jax.nn.softmax(s, axis=-1).astype(v_all.dtype)
        return jnp.einsum('bgrqk,bkgd->bqgrd', p, v_all)

    o = lax.map(attend_block, qb).transpose(1, 0, 2, 3, 4, 5)
    o_lat = o.reshape(b, n, HQ_B * HD_B) @ w_o
    o_ctx = ctx_self_attention(qc, kc, vc, None) @ w_o if need_ctx else None
    return o_lat, o_ctx


def moe_ffn(h, w_router, b_router, w1, b1, w2, b2):
    logits = (h @ w_router + b_router).astype(jnp.float32)
    top_v, top_i = lax.top_k(logits, TOP_K)
    top_w = jax.nn.softmax(top_v, axis=-1)
    gates = jnp.sum(jax.nn.one_hot(top_i, N_EXPERTS, dtype=jnp.float32) * top_w[..., None], axis=-2)
    gates = gates.astype(h.dtype)
    out = jnp.zeros_like(h)
    for e in range(N_EXPERTS):
        u = h @ w1[e] + b1[e]
        glu, lin = u[:, :D_FF], u[:, D_FF:]
        glu = jnp.minimum(glu, SWIGLU_LIMIT)
        lin = jnp.clip(lin, -SWIGLU_LIMIT, SWIGLU_LIMIT)
        act = glu * jax.nn.sigmoid(SWIGLU_ALPHA * glu) * (lin + 1)
        out = out + gates[:, e:e + 1] * (act @ w2[e] + b2[e])
    return out


def setup_inputs(seed: int = 0) -> dict:
    key = jax.random.key(seed)
    ks = jax.random.split(key, 20)
    D = D_MODEL
    nrm = jax.random.normal
    f32 = jnp.float32
    return {
        "x": nrm(ks[0], (BATCH, SEQ, D), f32),
        "c": nrm(ks[1], (BATCH, D), f32),
        "ctx": nrm(ks[2], (BATCH, CTX_LEN, D), f32),
        "c_ctx": nrm(ks[3], (D,), f32),
        "w_ada": nrm(ks[4], (DEPTH, D, 6 * D), f32) * (0.5 * D ** -0.5),
        "b_ada": nrm(ks[5], (DEPTH, 6 * D), f32) * 0.02,
        "norm_g": 1.0 + 0.1 * nrm(ks[6], (DEPTH, 4, D), f32),
        "a_w_qkv": nrm(ks[7], (N_LAYERS_A, D, (HQ_A + 2 * HKV_A) * HD_A), f32) * D ** -0.5,
        "a_w_o": nrm(ks[8], (N_LAYERS_A, HQ_A * HD_A, D), f32) * (HQ_A * HD_A) ** -0.5,
        "a_sink": nrm(ks[9], (N_LAYERS_A, HQ_A), f32) * 0.5,
        "b_w_qkv": nrm(ks[10], (N_LAYERS_B, D, (HQ_B + 2 * HKV_B) * HD_B), f32) * D ** -0.5,
        "b_q_norm": 1.0 + 0.1 * nrm(ks[11], (N_LAYERS_B, HD_B), f32),
        "b_k_norm": 1.0 + 0.1 * nrm(ks[12], (N_LAYERS_B, HD_B), f32),
        "b_w_o": nrm(ks[13], (N_LAYERS_B, HQ_B * HD_B, D), f32) * (HQ_B * HD_B) ** -0.5,
        "moe_w_router": nrm(ks[14], (DEPTH, D, N_EXPERTS), f32) * D ** -0.5,
        "moe_b_router": nrm(ks[15], (DEPTH, N_EXPERTS), f32) * 0.01,
        "moe_w1": nrm(ks[16], (DEPTH, N_EXPERTS, D, 2 * D_FF), f32) * D ** -0.5,
        "moe_b1": nrm(ks[17], (DEPTH, N_EXPERTS, 2 * D_FF), f32) * 0.01,
        "moe_w2": nrm(ks[18], (DEPTH, N_EXPERTS, D_FF, D), f32) * D_FF ** -0.5,
        "moe_b2": nrm(ks[19], (DEPTH, N_EXPERTS, D), f32) * 0.01,
    }


def reference(x, c, ctx, c_ctx, w_ada, b_ada, norm_g, a_w_qkv, a_w_o, a_sink,
              b_w_qkv, b_q_norm, b_k_norm, b_w_o,
              moe_w_router, moe_b_router, moe_w1, moe_b1, moe_w2, moe_b2):
    b, n, d = x.shape
    rows = n // GRID_W
    tabs_a = axial_rope_tables(rows, HD_A)
    tabs_b = axial_rope_tables(rows, HD_B)
    silu_c = jax.nn.silu(c)
    silu_cc = jax.nn.silu(c_ctx)
    for i in range(DEPTH):
        last = i == DEPTH - 1
        mod_lat = silu_c @ w_ada[i] + b_ada[i]
        mod_ctx = silu_cc @ w_ada[i] + b_ada[i]
        sh1, sc1, g1, sh2, sc2, g2 = [m[:, None, :] for m in jnp.split(mod_lat, 6, axis=-1)]
        csh1, csc1, cg1, csh2, csc2, cg2 = jnp.split(mod_ctx, 6, axis=-1)

        h_lat = modulate(rmsnorm(x, norm_g[i, 0]), sh1, sc1)
        h_ctx = modulate(rmsnorm(ctx, norm_g[i, 0]), csh1, csc1)
        if i % 2 == 0:
            la = i // 2
            a_lat, a_ctx = mixer_window_sink(h_lat, h_ctx, a_w_qkv[la], a_w_o[la], a_sink[la], tabs_a, not last)
        else:
            lb = i // 2
            a_lat, a_ctx = mixer_qknorm_gqa(h_lat, h_ctx, b_w_qkv[lb], b_q_norm[lb], b_k_norm[lb], b_w_o[lb], tabs_b, not last)
        x = x + g1 * rmsnorm(a_lat, norm_g[i, 1])
        if not last:
            ctx = ctx + cg1 * rmsnorm(a_ctx, norm_g[i, 1])

        f_lat_in = modulate(rmsnorm(x, norm_g[i, 2]), sh2, sc2).reshape(-1, d)
        if not last:
            f_ctx_in = modulate(rmsnorm(ctx, norm_g[i, 2]), csh2, csc2).reshape(-1, d)
            f_in = jnp.concatenate([f_lat_in, f_ctx_in], axis=0)
        else:
            f_in = f_lat_in
        f_out = moe_ffn(f_in, moe_w_router[i], moe_b_router[i], moe_w1[i], moe_b1[i], moe_w2[i], moe_b2[i])
        f_lat = f_out[:b * n].reshape(b, n, d)
        x = x + g2 * rmsnorm(f_lat, norm_g[i, 3])
        if not last:
            f_ctx = f_out[b * n:].reshape(b, ctx.shape[1], d)
            ctx = ctx + cg2 * rmsnorm(f_ctx, norm_g[i, 3])
    return x
```

```cpp
#include <hip/hip_runtime.h>
#include <cstdio>
#include <cstdint>

#define LAS __attribute__((address_space(3)))
#define GAS __attribute__((address_space(1)))
typedef unsigned short bf16;
typedef short bf16x8 __attribute__((ext_vector_type(8)));
typedef short s16x4 __attribute__((ext_vector_type(4)));
typedef float f32x4 __attribute__((ext_vector_type(4)));
typedef float f32x16 __attribute__((ext_vector_type(16)));
typedef unsigned u32x4 __attribute__((ext_vector_type(4)));
typedef unsigned u32x2 __attribute__((ext_vector_type(2)));
typedef int i32x4 __attribute__((ext_vector_type(4)));

constexpr int NB = 8, SEQ = 2048, CTXL = 256, DM = 1024, RPB = SEQ + CTXL, T = NB * RPB;
constexpr int NQA = 1280, NQB = 1536;
constexpr int NE = 32, TOPK = 4, CAP = T;
constexpr float EPS = 1e-6f;
constexpr int NIN = 20;

#define MK_N_LAUNCHES 1
#define DBG_STAGE 0
namespace pg8 {
#define PG8_LAS __attribute__((address_space(3)))
typedef unsigned short bf16_t;
typedef short bf16x8 __attribute__((ext_vector_type(8)));
typedef float f32x4 __attribute__((ext_vector_type(4)));
typedef unsigned u32x4 __attribute__((ext_vector_type(4)));
constexpr int BM = 256, BK = 64, HALF = 128, HTB = HALF * BK * 2  , STAGE_BYTES = 8 * HTB, NXCD = 8, WGM = 8;

__host__ __device__ __forceinline__ int lds_byte(int r, int c) { const int st = (r >> 4) * 2 + (c >> 5), rr = r & 15, cc = c & 31, ob = rr * 64 + cc * 2; return st * 1024 + (ob ^ (((ob >> 9) & 1) << 5)); }
__host__ __device__ __forceinline__ void stage_rc(int b, int& R, int& C) { const int st = b / 1024, sb = b % 1024, swz = sb ^ (((sb >> 9) & 1) << 5); R = (st >> 1) * 16 + swz / 64; C = (st & 1) * 32 + (swz % 64) / 2; }
__host__ __device__ __forceinline__ int perm32(int rho) { const int n = rho >> 4, i = rho & 15; return 8 * (i >> 2) + 4 * n + (i & 3); }

struct Unit { int pm, pn, cn, e, pos0, ne; };
struct Gemm { const bf16_t* A; const bf16_t* Bt; int M, N, K; };

struct StaticOrder {
    int nM, nN, nwg, G, c, skip9;
    __host__ __device__ void init(int M, int N, int G_, int c_, int skip9_ = 0) { nM = M / BM; nN = N / BM; nwg = nM * nN; G = G_; c = c_; skip9 = skip9_; }
    __host__ __device__ bool next(int i, Unit& u) const {
        const long L = (long)i * G + c; if (L >= nwg) return false;
        int wgid = (int)L; { const int q = nwg / NXCD, r = nwg % NXCD, xcd = wgid % NXCD, off = wgid / NXCD; wgid = (xcd < r ? xcd * (q + 1) : r * (q + 1) + (xcd - r) * q) + off; }
        const int nig = WGM * nN, gid = wgid / nig, fm = gid * WGM, gsz = (nM - fm) < WGM ? (nM - fm) : WGM;
        u.pm = fm + ((wgid % nig) % gsz); u.pn = (wgid % nig) / gsz; if (skip9) u.pm += u.pm / 8; u.cn = u.pn; u.e = 0; u.pos0 = 0; u.ne = 0; return true;
    }
    __device__ __forceinline__ void a_ready(const Unit&) const {}
    __device__ __forceinline__ void done(const Unit&) const {}
};

template <class Epi, class Sched, bool ALIGN_EPI = false, bool SP2 = false, bool GATHER = false>
__device__ __forceinline__ void gemm_phase(PG8_LAS unsigned char* lds, const Gemm g, const Sched& S, const Epi& E) {
    const int tid = threadIdx.x, wid = __builtin_amdgcn_readfirstlane(tid >> 6), lane = tid & 63, wr = wid >> 2, wc = wid & 3, fr = lane & 15, fq = lane >> 4;
    const int K = g.K, nt = K / BK;
    unsigned voffA[2], voffB[2]; int RA[2], CA[2];
#pragma unroll
    for (int i = 0; i < 2; ++i) { int R, C; stage_rc(tid * 16 + i * 8192, R, C); const int Rb = Epi::PERM ? ((R & ~31) + perm32(R & 31)) : R; RA[i] = R; CA[i] = C;
        voffA[i] = (unsigned)(R * K + C) * 2u; voffB[i] = (unsigned)(Rb * K + C) * 2u; }
    unsigned oc0[2], oc1[2], on0[2], on1[2];
#define PG8_GOFF(u, o0, o1) do { _Pragma("unroll") for (int _i = 0; _i < 2; ++_i) { if constexpr (GATHER) { \
        const int lim_ = (u).ne - 1; int p0_ = (u).pos0 + RA[_i], p1_ = p0_ + HALF; p0_ = p0_ < lim_ ? p0_ : lim_; p1_ = p1_ < lim_ ? p1_ : lim_; \
        const int t0_ = S.list[(size_t)(u).e * S.cap + p0_], t1_ = S.list[(size_t)(u).e * S.cap + p1_]; \
        (o0)[_i] = (unsigned)(t0_ * K + CA[_i]) * 2u; (o1)[_i] = (unsigned)(t1_ * K + CA[_i]) * 2u; } else { (o0)[_i] = voffA[_i]; (o1)[_i] = voffA[_i]; } } } while (0)
    const size_t kstep = (size_t)(BK * 2);
    const size_t hstep = (size_t)HALF * K * 2; const size_t hstepA = GATHER ? (size_t)0 : hstep;
    const size_t tstep = 2 * hstep;
    const unsigned ldsw = (unsigned)wid * 1024u;
    const int aoff = lds_byte(wr * 64 + fr, fq * 8), boff = lds_byte(wc * 32 + fr, fq * 8);
#define PG8_SA(b, h) (((b) * 2 + (h)) * HTB)
#define PG8_SB(b, h) ((4 + (b) * 2 + (h)) * HTB)
#define PG8_STAGE(bufoff, gbase, voff) do { _Pragma("unroll") for (int _i = 0; _i < 2; ++_i) \
        __builtin_amdgcn_global_load_lds((const unsigned*)((const char*)(gbase) + (voff)[_i]), (PG8_LAS unsigned*)(lds + (bufoff) + ldsw + _i * 8192), 16, 0, 0); } while (0)
#define PG8_LDA(dst, b, h) do { _Pragma("unroll") for (int m = 0; m < 4; ++m) _Pragma("unroll") for (int k = 0; k < 2; ++k) dst[m][k] = *(const PG8_LAS bf16x8*)(lds + PG8_SA(b, h) + aoff + m * 2048 + k * 1024); } while (0)
#define PG8_LDB(dst, b, h) do { _Pragma("unroll") for (int n = 0; n < 2; ++n) _Pragma("unroll") for (int k = 0; k < 2; ++k) dst[n][k] = *(const PG8_LAS bf16x8*)(lds + PG8_SB(b, h) + boff + n * 2048 + k * 1024); } while (0)
#define PG8_MMA(ai, bj, At, Bt) do { __builtin_amdgcn_s_setprio(1); _Pragma("unroll") for (int m = 0; m < 4; ++m) _Pragma("unroll") for (int n = 0; n < 2; ++n) _Pragma("unroll") for (int k = 0; k < 2; ++k) \
        acc[ai][bj][m][n] = __builtin_amdgcn_mfma_f32_16x16x32_bf16(Bt[n][k], At[m][k], acc[ai][bj][m][n], 0, 0, 0); __builtin_amdgcn_s_setprio(0); } while (0)
#define PG8_WAIT_V(n) asm volatile("s_waitcnt vmcnt(" #n ")" ::: "memory")
#define PG8_WAIT_L(n) asm volatile("s_waitcnt lgkmcnt(" #n ")" ::: "memory")
#define PG8_BAR __builtin_amdgcn_s_barrier()
#define PG8_SCHED __builtin_amdgcn_sched_barrier(0)
    Unit cur, nxt; int ui = 0;
    if (!S.next(0, cur)) return;
    f32x4 acc[2][2][4][2];
#pragma unroll
    for (int a = 0; a < 2; ++a)
#pragma unroll
        for (int b = 0; b < 2; ++b)
#pragma unroll
            for (int m = 0; m < 4; ++m)
#pragma unroll
                for (int n = 0; n < 2; ++n) acc[a][b][m][n] = (f32x4){0.f, 0.f, 0.f, 0.f};
    bf16x8 At[4][2], B0[2][2], B1[2][2];
    const char* cA = (const char*)g.A + (GATHER ? (size_t)0 : (size_t)cur.pm * tstep); PG8_GOFF(cur, oc0, oc1); const char* cB = (const char*)g.Bt + (size_t)cur.pn * tstep;
    S.a_ready(cur);
    if constexpr (SP2) {
        PG8_STAGE(PG8_SB(0, 0), cB, voffB); PG8_STAGE(PG8_SB(0, 1), cB + hstep, voffB); PG8_STAGE(PG8_SA(0, 0), cA, oc0); PG8_STAGE(PG8_SA(0, 1), cA + hstepA, oc1);
        if (wr == 1) PG8_BAR;
        PG8_WAIT_V(2); PG8_BAR;
        PG8_STAGE(PG8_SB(1, 0), cB + kstep, voffB); PG8_STAGE(PG8_SA(1, 0), cA + kstep, oc0); PG8_STAGE(PG8_SB(1, 1), cB + hstep + kstep, voffB);
        PG8_WAIT_V(6); PG8_BAR;
    } else {
        PG8_STAGE(PG8_SB(0, 0), cB, voffB); PG8_STAGE(PG8_SA(0, 0), cA, oc0); PG8_STAGE(PG8_SB(0, 1), cB + hstep, voffB); PG8_STAGE(PG8_SA(0, 1), cA + hstepA, oc1);
        if (wr == 1) PG8_BAR;
        PG8_WAIT_V(4); PG8_BAR;
        PG8_STAGE(PG8_SB(1, 0), cB + kstep, voffB); PG8_STAGE(PG8_SA(1, 0), cA + kstep, oc0); PG8_STAGE(PG8_SB(1, 1), cB + hstep + kstep, voffB);
        PG8_WAIT_V(6); PG8_BAR;
    }
    for (;;) {
        const bool has_next = S.next(ui + 1, nxt);
        const char* nA = (has_next && !GATHER) ? (const char*)g.A + (size_t)nxt.pm * tstep : cA;
        if (has_next) { PG8_GOFF(nxt, on0, on1); } else { _Pragma("unroll") for (int _i = 0; _i < 2; ++_i) { on0[_i] = oc0[_i]; on1[_i] = oc1[_i]; } } const char* nB = has_next ? (const char*)g.Bt + (size_t)nxt.pn * tstep : cB;
        for (int t = 0; t < nt; t += 2) {
            const bool last = (t == nt - 2);
            const char* a1 = cA + (size_t)(t + 1) * kstep;
            const char* a2 = last ? nA : cA + (size_t)(t + 2) * kstep; const char* b2 = last ? nB : cB + (size_t)(t + 2) * kstep;
            const char* a3 = a2 + kstep; const char* b3 = b2 + kstep;
            const unsigned s0[2] = {last ? on0[0] : oc0[0], last ? on0[1] : oc0[1]}, s1[2] = {last ? on1[0] : oc1[0], last ? on1[1] : oc1[1]};
            if (last && has_next) S.a_ready(nxt);
            if constexpr (SP2) {
            PG8_LDB(B0, 0, 0); PG8_LDB(B1, 0, 1); PG8_SCHED; PG8_LDA(At, 0, 0); PG8_STAGE(PG8_SA(1, 1), a1 + hstepA, oc1);
            PG8_WAIT_V(8); PG8_WAIT_L(0); PG8_BAR; PG8_MMA(0, 0, At, B0); PG8_MMA(0, 1, At, B1); PG8_BAR; PG8_SCHED;
            PG8_LDA(At, 0, 1); PG8_STAGE(PG8_SB(0, 0), b2, voffB); PG8_STAGE(PG8_SB(0, 1), b2 + hstep, voffB); PG8_STAGE(PG8_SA(0, 0), a2, s0);
            PG8_WAIT_V(8); PG8_WAIT_L(0); PG8_BAR; PG8_MMA(1, 0, At, B0); PG8_MMA(1, 1, At, B1); PG8_BAR; PG8_SCHED;
            PG8_LDB(B0, 1, 0); PG8_LDB(B1, 1, 1); PG8_SCHED; PG8_LDA(At, 1, 0); PG8_STAGE(PG8_SA(0, 1), a2 + hstepA, s1);
            PG8_WAIT_V(8); PG8_WAIT_L(0); PG8_BAR; PG8_MMA(0, 0, At, B0); PG8_MMA(0, 1, At, B1); PG8_BAR; PG8_SCHED;
            PG8_LDA(At, 1, 1); PG8_STAGE(PG8_SB(1, 0), b3, voffB); PG8_STAGE(PG8_SB(1, 1), b3 + hstep, voffB); PG8_STAGE(PG8_SA(1, 0), a3, s0);
            PG8_WAIT_V(8); PG8_WAIT_L(0); PG8_BAR; PG8_MMA(1, 0, At, B0); PG8_MMA(1, 1, At, B1); PG8_BAR; PG8_SCHED;
            } else {
            PG8_LDB(B0, 0, 0); PG8_SCHED; PG8_LDA(At, 0, 0); PG8_STAGE(PG8_SA(1, 1), a1 + hstepA, oc1);
            PG8_WAIT_L(8); PG8_BAR; PG8_WAIT_L(0); PG8_MMA(0, 0, At, B0); PG8_BAR; PG8_SCHED;
            PG8_LDB(B1, 0, 1); PG8_STAGE(PG8_SB(0, 0), b2, voffB);
            PG8_BAR; PG8_WAIT_L(0); PG8_MMA(0, 1, At, B1); PG8_BAR;
            PG8_LDA(At, 0, 1); PG8_STAGE(PG8_SA(0, 0), a2, s0);
            PG8_BAR; PG8_WAIT_L(0); PG8_MMA(1, 0, At, B0); PG8_BAR; PG8_SCHED;
            PG8_STAGE(PG8_SB(0, 1), b2 + hstep, voffB);
            PG8_WAIT_V(6); PG8_BAR; PG8_MMA(1, 1, At, B1); PG8_BAR;
            PG8_LDB(B0, 1, 0); PG8_SCHED; PG8_LDA(At, 1, 0); PG8_STAGE(PG8_SA(0, 1), a2 + hstepA, s1);
            PG8_WAIT_L(8); PG8_BAR; PG8_WAIT_L(0); PG8_MMA(0, 0, At, B0); PG8_BAR; PG8_SCHED;
            PG8_LDB(B1, 1, 1); PG8_STAGE(PG8_SB(1, 0), b3, voffB);
            PG8_BAR; PG8_WAIT_L(0); PG8_MMA(0, 1, At, B1); PG8_BAR;
            PG8_LDA(At, 1, 1); PG8_STAGE(PG8_SA(1, 0), a3, s0);
            PG8_BAR; PG8_WAIT_L(0); PG8_MMA(1, 0, At, B0); PG8_BAR; PG8_SCHED;
            PG8_STAGE(PG8_SB(1, 1), b3 + hstep, voffB);
            PG8_WAIT_V(6); PG8_BAR; PG8_MMA(1, 1, At, B1); PG8_BAR;
            }
        }
        if constexpr (ALIGN_EPI) { if (wr == 0) PG8_BAR; }
        if constexpr (!Epi::AFTER_DRAIN) { E(acc, cur, wr, wc, fr, fq); S.done(cur); }
        if (!has_next) break;
#pragma unroll
        for (int a = 0; a < 2; ++a)
#pragma unroll
            for (int b = 0; b < 2; ++b)
#pragma unroll
                for (int m = 0; m < 4; ++m)
#pragma unroll
                    for (int n = 0; n < 2; ++n) acc[a][b][m][n] = (f32x4){0.f, 0.f, 0.f, 0.f};
        cur = nxt; cA = nA; cB = nB; ++ui;
        _Pragma("unroll") for (int _i = 0; _i < 2; ++_i) { oc0[_i] = on0[_i]; oc1[_i] = on1[_i]; }
        if constexpr (ALIGN_EPI) { if (wr == 1) PG8_BAR; }
    }
    PG8_WAIT_V(0);
    if constexpr (!ALIGN_EPI) { if (wr == 0) PG8_BAR; }
    PG8_BAR;
    if constexpr (Epi::AFTER_DRAIN) { E.fused(acc, cur, wr, wc, fr, fq, lds, wid, lane); S.done(cur); }
#undef PG8_GOFF
#undef PG8_SA
#undef PG8_SB
#undef PG8_STAGE
#undef PG8_LDA
#undef PG8_LDB
#undef PG8_MMA
#undef PG8_WAIT_V
#undef PG8_WAIT_L
#undef PG8_BAR
#undef PG8_SCHED
}
}

namespace pg8 {
__device__ __forceinline__ unsigned cvt_pk_bf16(float lo, float hi) { unsigned r; asm volatile("v_cvt_pk_bf16_f32 %0, %1, %2" : "=v"(r) : "v"(lo), "v"(hi)); return r; }
struct EpiStore {
    static constexpr bool PERM = true, AFTER_DRAIN = false;
    bf16_t* O; int ldc; const float* bias; int bias_stride;
    __device__ __forceinline__ void operator()(const f32x4 (&acc)[2][2][4][2], const Unit& u, int wr, int wc, int fr, int fq) const {
        const int row0 = u.pm * BM + wr * 64 + fr, col0 = u.cn * BM + wc * 32 + 8 * fq;
        f32x4 bv[2][2];
#pragma unroll
        for (int bj = 0; bj < 2; ++bj)
#pragma unroll
            for (int n = 0; n < 2; ++n) bv[bj][n] = bias ? *(const f32x4*)(bias + (size_t)u.e * bias_stride + col0 + bj * HALF + 4 * n) : (f32x4){0.f, 0.f, 0.f, 0.f};
#pragma unroll
        for (int ai = 0; ai < 2; ++ai)
#pragma unroll
            for (int m = 0; m < 4; ++m) { bf16_t* rowp = O + (size_t)(row0 + ai * HALF + m * 16) * ldc + col0;
#pragma unroll
                for (int bj = 0; bj < 2; ++bj) { const f32x4 v0 = acc[ai][bj][m][0] + bv[bj][0], v1 = acc[ai][bj][m][1] + bv[bj][1];
                    u32x4 w; w.x = cvt_pk_bf16(v0[0], v0[1]); w.y = cvt_pk_bf16(v0[2], v0[3]); w.z = cvt_pk_bf16(v1[0], v1[1]); w.w = cvt_pk_bf16(v1[2], v1[3]);
                    *(u32x4*)(rowp + bj * HALF) = w; } }
    }
};
struct EpiSwiglu {
    static constexpr bool PERM = true, AFTER_DRAIN = false;
    bf16_t* O; const float* b1;
    __device__ __forceinline__ void operator()(const f32x4 (&acc)[2][2][4][2], const Unit& u, int wr, int wc, int fr, int fq) const {
        typedef unsigned u32x2v __attribute__((ext_vector_type(2)));
        const int row0 = u.pm * BM + wr * 64 + fr, col0 = u.cn * 128 + wc * 16 + 4 * fq;
        f32x4 bg[2], bl[2];
#pragma unroll
        for (int bj = 0; bj < 2; ++bj) { bg[bj] = *(const f32x4*)(b1 + (size_t)u.e * 2048 + col0 + bj * 64); bl[bj] = *(const f32x4*)(b1 + (size_t)u.e * 2048 + 1024 + col0 + bj * 64); }
#pragma unroll
        for (int ai = 0; ai < 2; ++ai)
#pragma unroll
            for (int m = 0; m < 4; ++m) { bf16_t* rowp = O + (size_t)(row0 + ai * HALF + m * 16) * 1024 + col0;
#pragma unroll
                for (int bj = 0; bj < 2; ++bj) { const f32x4 g = acc[ai][bj][m][0] + bg[bj], l = acc[ai][bj][m][1] + bl[bj]; float a[4];
#pragma unroll
                    for (int i = 0; i < 4; ++i) { const float gg = fminf(g[i], 7.0f), ll = fminf(fmaxf(l[i], -7.0f), 7.0f);
                        const float sg = __builtin_amdgcn_rcpf(1.0f + __builtin_amdgcn_exp2f(gg * (-1.702f * 1.4426950408889634f)));
                        a[i] = gg * sg * (ll + 1.0f); }
                    u32x2v w; w.x = cvt_pk_bf16(a[0], a[1]); w.y = cvt_pk_bf16(a[2], a[3]);
                    *(u32x2v*)(rowp + bj * 64) = w; } }
    }
};
struct MoeOrder {
    const PG8_LAS int* tab; int nN, G, c; const int* list; int cap;
    __device__ __forceinline__ bool next(int i, Unit& u) const {
        const int L = i * G + c, TT = tab[65]; if (L >= TT * nN) return false;
        int e = 0;
#pragma unroll 4
        for (int k = 1; k < 32; ++k) e += (L >= tab[32 + k] * nN) ? 1 : 0;
        const int t0 = tab[32 + e], mt = tab[33 + e] - t0, local = L - t0 * nN, pml = local % mt, pnl = local / mt;
        u.pm = __builtin_amdgcn_readfirstlane(t0 + pml); u.pn = __builtin_amdgcn_readfirstlane(e * nN + pnl); u.cn = __builtin_amdgcn_readfirstlane(pnl);
        u.e = __builtin_amdgcn_readfirstlane(e); u.pos0 = __builtin_amdgcn_readfirstlane(pml * 256); u.ne = __builtin_amdgcn_readfirstlane(tab[e]); return true;
    }
    __device__ __forceinline__ void a_ready(const Unit&) const {}
    __device__ __forceinline__ void done(const Unit&) const {}
};
}

namespace att {
#define SBAR() __builtin_amdgcn_sched_barrier(0)
constexpr float THR = 8.f;
__device__ __forceinline__ int crow(int r, int hi) { return (r & 3) + 8 * (r >> 2) + 4 * hi; }
__device__ __forceinline__ unsigned cvtpk(float lo, float hi) { unsigned r; asm volatile("v_cvt_pk_bf16_f32 %0, %1, %2" : "=v"(r) : "v"(lo), "v"(hi)); return r; }
template <int D> struct Cst { static constexpr float SCALE = (D == 64) ? 0.125f : 0.088388347648318440f; };
template <int D> __device__ __forceinline__ int kswz(int row, int colB) {
    if constexpr (D == 128) return row * 256 + (colB ^ ((row & 15) << 4));
    else return row * 128 + (colB ^ (((row >> 1) & 7) << 4));
}
template <int D> __device__ __forceinline__ void partialSM(f32x16& p0, f32x16& p1, float& m_reg, float& mn, float& alpha) {
  constexpr float SCALE = Cst<D>::SCALE, C = SCALE * 1.4426950408889634f;
  float pmax = p0[0];
#pragma unroll
  for (int r = 1; r < 16; ++r) pmax = fmaxf(pmax, p0[r]);
#pragma unroll
  for (int r = 0; r < 16; ++r) pmax = fmaxf(pmax, p1[r]);
  { auto rr = __builtin_amdgcn_permlane32_swap(__float_as_uint(pmax), __float_as_uint(pmax), false, false);
    pmax = fmaxf(__uint_as_float(rr[0]), __uint_as_float(rr[1])); }
  if (__builtin_expect(__all(pmax - m_reg <= THR / SCALE), 1)) { mn = m_reg; alpha = 1.f; }
  else { mn = fmaxf(m_reg, pmax); alpha = __builtin_amdgcn_exp2f((m_reg - mn) * C); m_reg = mn; }
  const float mnC = -mn * C;
#pragma unroll
  for (int r = 0; r < 16; ++r) p0[r] = fmaf(p0[r], C, mnC);
#pragma unroll
  for (int r = 0; r < 16; ++r) p1[r] = fmaf(p1[r], C, mnC);
#pragma unroll
  for (int r = 0; r < 16; ++r) p0[r] = __builtin_amdgcn_exp2f(p0[r]);
}
__device__ __forceinline__ void finishSM(f32x16& p0, f32x16& p1, float alpha, float& l_reg, bf16x8& pa0, bf16x8& pa1, bf16x8& pa2, bf16x8& pa3) {
#pragma unroll
  for (int r = 0; r < 16; ++r) p1[r] = __builtin_amdgcn_exp2f(p1[r]);
  float ps = 0;
#pragma unroll
  for (int r = 0; r < 16; ++r) ps += p0[r];
#pragma unroll
  for (int r = 0; r < 16; ++r) ps += p1[r];
  { auto rr = __builtin_amdgcn_permlane32_swap(__float_as_uint(ps), __float_as_uint(ps), false, false);
    ps = __uint_as_float(rr[0]) + __uint_as_float(rr[1]); }
  l_reg = l_reg * alpha + ps;
#define PK4(P, BASE, OUT) do { unsigned a0 = cvtpk(P[BASE + 0], P[BASE + 1]), a1 = cvtpk(P[BASE + 2], P[BASE + 3]);   \
    unsigned b0 = cvtpk(P[BASE + 4], P[BASE + 5]), b1 = cvtpk(P[BASE + 6], P[BASE + 7]);                              \
    auto r0 = __builtin_amdgcn_permlane32_swap(a0, b0, false, false); auto r1 = __builtin_amdgcn_permlane32_swap(a1, b1, false, false); \
    u32x4 w = {r0[0], r1[0], r0[1], r1[1]}; OUT = *reinterpret_cast<bf16x8*>(&w); } while (0)
  PK4(p0, 0, pa0); PK4(p0, 8, pa1); PK4(p1, 0, pa2); PK4(p1, 8, pa3);
#undef PK4
}
__device__ __forceinline__ void wmask(f32x16& p0, f32x16& p1, int dq) {
#pragma unroll
  for (int r = 0; r < 16; ++r) { const int d0 = dq + (r & 3) + 8 * (r >> 2), d1 = d0 + 32;
    if (d0 > 128 || d0 < -128) p0[r] = -1e30f;
    if (d1 > 128 || d1 < -128) p1[r] = -1e30f; }
}
template <int D> __device__ __forceinline__ void qkt(f32x16& p0, f32x16& p1, const char* Ks, const bf16x8* qr, int r32, int hi) {
  p0 = f32x16{}; p1 = f32x16{};
#pragma unroll
  for (int d0 = 0; d0 < D / 16; ++d0) { const int cb = (d0 * 16 + hi * 8) * 2;
    bf16x8 b0 = *reinterpret_cast<const bf16x8*>(Ks + kswz<D>(r32, cb));
    bf16x8 b1 = *reinterpret_cast<const bf16x8*>(Ks + kswz<D>(32 + r32, cb));
    p0 = __builtin_amdgcn_mfma_f32_32x32x16_bf16(b0, qr[d0], p0, 0, 0, 0);
    p1 = __builtin_amdgcn_mfma_f32_32x32x16_bf16(b1, qr[d0], p1, 0, 0, 0); }
}
template <int D> __device__ __forceinline__ int v_st(int k, int c) { const int kk = (k & ~0xC) | ((k & 4) << 1) | ((k & 8) >> 1); return ((kk >> 3) * (D / 32) + (c >> 5)) * 512 + ((kk & 7) * 32 + (c & 31)) * 2; }
__device__ __forceinline__ int v_rd_base(int lane) { return ((lane & 3) << 3) | (((lane >> 2) & 3) << 6) | (((lane >> 4) & 1) << 5) | (((lane >> 5) & 1) << 8); }
template <int D> constexpr int v_rd_off(int d0, int ks, int half) { return ((2 * ks + half) * (D / 32) + d0) * 512; }
template <int OFF> __device__ __forceinline__ s16x4 tr_read(int vb) {
  s16x4 r; asm volatile("ds_read_b64_tr_b16 %0, %1 offset:%2" : "=&v"(r) : "v"(vb), "i"(OFF) : "memory"); return r;
}
template <int D, int D0> __device__ __forceinline__ void pv_one(f32x16& od, int vb, bf16x8 pa0, bf16x8 pa1, bf16x8 pa2, bf16x8 pa3) {
  const s16x4 l0 = tr_read<v_rd_off<D>(D0, 0, 0)>(vb), h0 = tr_read<v_rd_off<D>(D0, 0, 1)>(vb), l1 = tr_read<v_rd_off<D>(D0, 1, 0)>(vb), h1 = tr_read<v_rd_off<D>(D0, 1, 1)>(vb);
  const s16x4 l2 = tr_read<v_rd_off<D>(D0, 2, 0)>(vb), h2 = tr_read<v_rd_off<D>(D0, 2, 1)>(vb), l3 = tr_read<v_rd_off<D>(D0, 3, 0)>(vb), h3 = tr_read<v_rd_off<D>(D0, 3, 1)>(vb);
  asm volatile("s_waitcnt lgkmcnt(0)" ::: "memory"); SBAR();
#define PK(L, H) (bf16x8){L[0], L[1], L[2], L[3], H[0], H[1], H[2], H[3]}
  od = __builtin_amdgcn_mfma_f32_32x32x16_bf16(pa0, PK(l0, h0), od, 0, 0, 0);
  od = __builtin_amdgcn_mfma_f32_32x32x16_bf16(pa1, PK(l1, h1), od, 0, 0, 0);
  od = __builtin_amdgcn_mfma_f32_32x32x16_bf16(pa2, PK(l2, h2), od, 0, 0, 0);
  od = __builtin_amdgcn_mfma_f32_32x32x16_bf16(pa3, PK(l3, h3), od, 0, 0, 0);
#undef PK
}
template <int D> __device__ __forceinline__ void pv_all(f32x16* o, int vb, bf16x8 pa0, bf16x8 pa1, bf16x8 pa2, bf16x8 pa3) {
  pv_one<D, 0>(o[0], vb, pa0, pa1, pa2, pa3); pv_one<D, 1>(o[1], vb, pa0, pa1, pa2, pa3);
  if constexpr (D == 128) { pv_one<D, 2>(o[2], vb, pa0, pa1, pa2, pa3); pv_one<D, 3>(o[3], vb, pa0, pa1, pa2, pa3); }
}
template <int D> constexpr int attn_lds_bytes() { return 4 * 64 * D * 2 + 8 * 64 * 4; }

template <int D, bool MASK, int LD>
__device__ __forceinline__ void attn_unit(const bf16* __restrict__ Qb, const bf16* __restrict__ Kb, const bf16* __restrict__ Vb, bf16* __restrict__ Ob,
                                          int nwin, int wstart, int cstart, int NT, int qpos0, float m0, float l0, char* lds) {
  constexpr int ND0 = D / 16, NDO = D / 32, TPR = D / 8, RPP = 512 / TPR, NP = 64 / RPP, SHM_V = 64 * D * 2, SHM_K = 64 * D * 2, LDO = 1024;
  const int tid = threadIdx.x, wid = tid >> 6, lane = tid & 63, r32 = lane & 31, hi = lane >> 5;
  char* V_lds = lds; char* K_lds = lds + 2 * SHM_V;
  float* ws = (float*)(lds + 2 * SHM_V + 2 * SHM_K) + wid * 64; float* li_l = ws; float* al_l = ws + 32;
  float m_reg = m0, l_reg = l0; f32x16 o[NDO]; bf16x8 qr[ND0];
#pragma unroll
  for (int d = 0; d < NDO; ++d) o[d] = f32x16{};
  const bf16* Qw = Qb + (long)(wid * 32 + r32) * LD + hi * 8;
#pragma unroll
  for (int d0 = 0; d0 < ND0; ++d0) qr[d0] = *reinterpret_cast<const bf16x8*>(Qw + d0 * 16);
  const int sr = tid / TPR, sc = (tid % TPR) * 8;
  int vst[NP], kst[NP];
#pragma unroll
  for (int p = 0; p < NP; ++p) { vst[p] = v_st<D>(sr + p * RPP, sc); kst[p] = kswz<D>(sr + p * RPP, sc * 2); }
  const int vb0 = (int)(uintptr_t)V_lds + v_rd_base(lane);
  const int dqb = 4 * hi - (qpos0 + wid * 32 + r32);
  bf16x8 sv0[NP], sk0[NP], sv1[NP], sk1[NP];
#define KROW(j) ((j) < nwin ? wstart + 64 * (j) : cstart + 64 * ((j) - nwin))
#define SLOAD(SV, SK, j) do { const long rb_ = (long)KROW(j) + sr; _Pragma("unroll") for (int p = 0; p < NP; ++p) { \
    SV[p] = *reinterpret_cast<const bf16x8*>(Vb + (rb_ + p * RPP) * LD + sc); SK[p] = *reinterpret_cast<const bf16x8*>(Kb + (rb_ + p * RPP) * LD + sc); } } while (0)
#define SWRITE(b, SV, SK) do { _Pragma("unroll") for (int p = 0; p < NP; ++p) { *reinterpret_cast<bf16x8*>(V_lds + (b) * SHM_V + vst[p]) = SV[p]; \
    *reinterpret_cast<bf16x8*>(K_lds + (b) * SHM_K + kst[p]) = SK[p]; } } while (0)
#define SWAIT() do { if constexpr (NP == 2) asm volatile("s_waitcnt vmcnt(4)" ::: "memory"); else asm volatile("s_waitcnt vmcnt(2)" ::: "memory"); } while (0)
#define RESC(a) do { if (__any((a) < 1.f)) { if (hi == 0) al_l[r32] = (a); asm volatile("s_waitcnt lgkmcnt(0)" ::: "memory"); \
    _Pragma("unroll") for (int d = 0; d < NDO; ++d) _Pragma("unroll") for (int r = 0; r < 16; ++r) o[d][r] *= al_l[crow(r, hi)]; } } while (0)
#define MASKT(PA, PB, j) do { if constexpr (MASK) { if ((j) < nwin) wmask(PA, PB, wstart + 64 * (j) + dqb); } } while (0)
  f32x16 pA0, pA1, pB0, pB1; float mnA, mnB, alA, alB; bf16x8 pa0, pa1, pa2, pa3;
  SLOAD(sv0, sk0, 0); asm volatile("s_waitcnt vmcnt(0)" ::: "memory"); SWRITE(0, sv0, sk0); __syncthreads();
  qkt<D>(pA0, pA1, K_lds, qr, r32, hi); MASKT(pA0, pA1, 0); partialSM<D>(pA0, pA1, m_reg, mnA, alA);
  SLOAD(sv1, sk1, 1); if (2 < NT) SLOAD(sv0, sk0, 2);
  SWAIT(); SWRITE(1, sv1, sk1); __syncthreads();
  for (int j = 1; j + 1 < NT; j += 2) {
    SBAR(); qkt<D>(pB0, pB1, K_lds + SHM_K, qr, r32, hi);
    finishSM(pA0, pA1, alA, l_reg, pa0, pa1, pa2, pa3); SBAR();
    SLOAD(sv1, sk1, j + 2); SBAR();
    pv_all<D>(o, vb0, pa0, pa1, pa2, pa3); MASKT(pB0, pB1, j); partialSM<D>(pB0, pB1, m_reg, mnB, alB);
    __syncthreads(); SWAIT(); SWRITE(0, sv0, sk0);
    RESC(alB); __syncthreads();
    SBAR(); qkt<D>(pA0, pA1, K_lds, qr, r32, hi);
    finishSM(pB0, pB1, alB, l_reg, pa0, pa1, pa2, pa3); SBAR();
    if (j + 3 < NT) SLOAD(sv0, sk0, j + 3); SBAR();
    pv_all<D>(o, vb0 + SHM_V, pa0, pa1, pa2, pa3); MASKT(pA0, pA1, j + 1); partialSM<D>(pA0, pA1, m_reg, mnA, alA);
    __syncthreads(); SWAIT(); SWRITE(1, sv1, sk1);
    RESC(alA); __syncthreads();
  }
  SBAR(); qkt<D>(pB0, pB1, K_lds + SHM_K, qr, r32, hi);
  finishSM(pA0, pA1, alA, l_reg, pa0, pa1, pa2, pa3); SBAR();
  pv_all<D>(o, vb0, pa0, pa1, pa2, pa3); MASKT(pB0, pB1, NT - 1); partialSM<D>(pB0, pB1, m_reg, mnB, alB);
  __syncthreads(); RESC(alB);
  finishSM(pB0, pB1, alB, l_reg, pa0, pa1, pa2, pa3); SBAR();
  pv_all<D>(o, vb0 + SHM_V, pa0, pa1, pa2, pa3);
  if (hi == 0) li_l[r32] = l_reg; asm volatile("s_waitcnt lgkmcnt(0)" ::: "memory");
  float rli[16];
#pragma unroll
  for (int r = 0; r < 16; ++r) rli[r] = __builtin_amdgcn_rcpf(li_l[crow(r, hi)]);
  bf16* Ow = Ob + (long)(wid * 32) * LDO;
#pragma unroll
  for (int r = 0; r < 16; ++r) { const int orow = crow(r, hi);
#pragma unroll
    for (int d0 = 0; d0 < NDO; ++d0) { const float v = o[d0][r] * rli[r]; Ow[(long)orow * LDO + d0 * 32 + r32] = (bf16)(cvtpk(v, v) & 0xffffu); } }
#undef KROW
#undef SLOAD
#undef SWRITE
#undef SWAIT
#undef RESC
#undef MASKT
}
}

#ifndef MK_N_LAUNCHES
#define MK_N_LAUNCHES 1
#endif
#ifndef DBG_STAGE
#define DBG_STAGE 0
#endif
constexpr int NPH = 18;

constexpr size_t MiB = 1u << 20;
constexpr size_t WS_CTL = 0, CTL_ZERO_BYTES = 1 * MiB;
constexpr size_t WS_MODS = 1 * MiB;
constexpr size_t WS_ROPE = WS_MODS + 512 * 1024;
constexpr size_t WS_WQA = 2 * MiB, WS_WOA = 5 * MiB, WS_WQB = 7 * MiB, WS_WOB = 10 * MiB;
constexpr size_t WS_W1 = 16 * MiB;
constexpr size_t WS_W2 = 272 * MiB;
constexpr size_t WS_H = 400 * MiB;
constexpr size_t WS_QKV = 436 * MiB;
constexpr size_t WS_AO = 490 * MiB;
constexpr size_t WS_AP = 526 * MiB;
constexpr size_t WS_XB = 562 * MiB;
constexpr size_t WS_RT = 634 * MiB;
constexpr size_t RT_STRIDE = (size_t)T * 4 * 4;
constexpr size_t WS_LIST = 635 * MiB;
constexpr size_t WS_ACT = 638 * MiB;
constexpr size_t WS_Y = 798 * MiB;
constexpr size_t WS_END = 958 * MiB;
static_assert(WS_ROPE + 6144 * 4 <= WS_WQA && WS_WOB + 2 * MiB <= WS_W1 && WS_LIST + (size_t)NE * CAP * 4 <= WS_ACT && WS_RT + 3 * RT_STRIDE <= WS_LIST, "d_ws map");
constexpr int CW_BAR = 4096;
constexpr int CW_CNT = 8192;

constexpr int RING_BYTES = 131072;
constexpr int MISC_OFF = RING_BYTES;
constexpr int TAB_OFF = RING_BYTES + 256;
constexpr int RSCR_OFF = RING_BYTES + 1024;
constexpr int LDS_BYTES = 147456;

#define LDS_WAIT() asm volatile("s_waitcnt lgkmcnt(0)" ::: "memory")
#define VM_WAIT() asm volatile("s_waitcnt vmcnt(0)" ::: "memory")
__device__ __forceinline__ unsigned f2bf(float f) { unsigned u = __builtin_bit_cast(unsigned, f); return (u + 0x7fffu + ((u >> 16) & 1u)) >> 16; }
__device__ __forceinline__ unsigned pk2(float lo, float hi) { return f2bf(lo) | (f2bf(hi) << 16); }
__device__ __forceinline__ float bflo(unsigned w) { return __builtin_bit_cast(float, w << 16); }
__device__ __forceinline__ float bfhi(unsigned w) { return __builtin_bit_cast(float, w & 0xffff0000u); }

#define XB_TMO      128
#define XB_XCNT(j)  (256  + 64 * (j))
#define XB_XSUB(j)  (1280 + 64 * (j))
#define XB_XGEN(j)  (2304 + 64 * (j))
#define XB_TOP      3328
#define XB_TOPGEN   3392
#define XCD_BAR_WORDS 3456
#define XB_SPIN_CAP (1u << 18)

__device__ __forceinline__ unsigned xb_ld(unsigned* p)              { return __hip_atomic_load(p, __ATOMIC_RELAXED, __HIP_MEMORY_SCOPE_AGENT); }
__device__ __forceinline__ unsigned xb_add(unsigned* p, unsigned v) { return __hip_atomic_fetch_add(p, v, __ATOMIC_RELAXED, __HIP_MEMORY_SCOPE_AGENT); }
__device__ __forceinline__ unsigned xb_xcc_id() { return (unsigned)__builtin_amdgcn_s_getreg((3 << 11) | 20) & 0xFu; }
#define XB_SPIN(cond, bar) do { unsigned _sp = 0; while (cond) { __builtin_amdgcn_s_sleep(1); \
    if ((++_sp & 255u) == 0u) { if (xb_ld(&(bar)[XB_TMO])) break; if (_sp > XB_SPIN_CAP) { atomicAdd(&(bar)[XB_TMO], 1u); break; } } } } while (0)

struct XcdBarrier {
    unsigned* bar; unsigned x;
    volatile LAS unsigned* st;
};

__device__ __forceinline__ XcdBarrier xcd_barrier_post(unsigned* bar, volatile LAS unsigned* st) {
    XcdBarrier b; b.bar = bar; b.x = xb_xcc_id(); b.st = st;
    if (threadIdx.x == 0) (void)xb_add(&bar[XB_XCNT(b.x)], 1u);
    return b;
}
__device__ __forceinline__ void xcd_barrier_complete(unsigned* bar, unsigned x, unsigned& nloc, unsigned& nx) {
    const unsigned G = gridDim.x * gridDim.y * gridDim.z;
    unsigned sum, cnt, mine, sp = 0u;
    for (;;) {
        sum = 0u; cnt = 0u; mine = 0u;
#pragma unroll
        for (unsigned j = 0; j < 16; ++j) { const unsigned c = xb_ld(&bar[XB_XCNT(j)]); sum += c; cnt += (c > 0u) ? 1u : 0u; mine = (j == x) ? c : mine; }
        if (sum == G) break;
        __builtin_amdgcn_s_sleep(1);
        if ((++sp & 255u) == 0u) { if (xb_ld(&bar[XB_TMO])) break; if (sp > XB_SPIN_CAP) { atomicAdd(&bar[XB_TMO], 1u); break; } }
    }
    nloc = mine > 0u ? mine : 1u; nx = cnt > 0u ? cnt : 1u;
}

__device__ __forceinline__ void xcd_barrier(const XcdBarrier& b) {
    asm volatile("s_waitcnt vmcnt(0)" ::: "memory");
    __syncthreads();
    if (threadIdx.x == 0) {
        unsigned* bar = b.bar;
        __builtin_amdgcn_s_waitcnt(0);
        unsigned nloc = b.st[0], nx = b.st[1];
        if (nloc == 0u) { xcd_barrier_complete(bar, b.x, nloc, nx); b.st[0] = nloc; b.st[1] = nx; }
        const unsigned old = xb_add(&bar[XB_XSUB(b.x)], 1u);
        const unsigned gen = old / nloc;
        if (old + 1u == (gen + 1u) * nloc) {
            __builtin_amdgcn_fence(__ATOMIC_RELEASE, "agent");
            asm volatile("s_waitcnt vmcnt(0)" ::: "memory");
            const unsigned og = xb_add(&bar[XB_TOP], 1u);
            const unsigned tg = og / nx;
            if (og + 1u == (tg + 1u) * nx) xb_add(&bar[XB_TOPGEN], 1u);
            else XB_SPIN(xb_ld(&bar[XB_TOPGEN]) == tg, bar);
            __builtin_amdgcn_fence(__ATOMIC_ACQUIRE, "agent");
            xb_add(&bar[XB_XGEN(b.x)], 1u);
            asm volatile("s_waitcnt vmcnt(0)" ::: "memory");
        } else {
            XB_SPIN(xb_ld(&bar[XB_XGEN(b.x)]) == gen, bar);
            __builtin_amdgcn_fence(__ATOMIC_ACQUIRE, "agent");
            asm volatile("s_waitcnt vmcnt(0)" ::: "memory");
        }
    }
    __syncthreads();
}

struct Args { const float* in[NIN]; float* out; unsigned char* ws; int ph_lo, ph_hi; };

__device__ __forceinline__ float wave_sum(float v) {
#pragma unroll
    for (int o = 1; o < 64; o <<= 1) v += __shfl_xor(v, o);
    return v;
}
struct Row { f32x4 v[4]; };
__device__ __forceinline__ Row ld_row_f32(const float* p, int lane) { Row r; const f32x4* q = (const f32x4*)p + lane;
#pragma unroll
    for (int j = 0; j < 4; ++j) r.v[j] = q[64 * j];
    return r; }
__device__ __forceinline__ Row ld_row_bf16(const bf16* p, int lane) { Row r; const u32x2* q = (const u32x2*)p + lane;
#pragma unroll
    for (int j = 0; j < 4; ++j) { const u32x2 w = q[64 * j]; r.v[j] = (f32x4){bflo(w.x), bfhi(w.x), bflo(w.y), bfhi(w.y)}; }
    return r; }
__device__ __forceinline__ void st_row_f32(float* p, int lane, const Row& r) { f32x4* q = (f32x4*)p + lane;
#pragma unroll
    for (int j = 0; j < 4; ++j) q[64 * j] = r.v[j]; }
__device__ __forceinline__ void st_row_bf16(bf16* p, int lane, const Row& r) { u32x2* q = (u32x2*)p + lane;
#pragma unroll
    for (int j = 0; j < 4; ++j) { u32x2 w; w.x = pk2(r.v[j].x, r.v[j].y); w.y = pk2(r.v[j].z, r.v[j].w); q[64 * j] = w; } }
__device__ __forceinline__ float row_rs(const Row& r) {
    float s = 0.f;
#pragma unroll
    for (int j = 0; j < 4; ++j) s += (r.v[j].x * r.v[j].x + r.v[j].y * r.v[j].y) + (r.v[j].z * r.v[j].z + r.v[j].w * r.v[j].w);
    return 1.0f / sqrtf(wave_sum(s) * (1.0f / DM) + EPS);
}
__device__ __forceinline__ Row norm_mod(const Row& x, float rs, const float* g, const float* sh, const float* sc, int lane) {
    const Row G = ld_row_f32(g, lane), SH = ld_row_f32(sh, lane), SC = ld_row_f32(sc, lane); Row h;
#pragma unroll
    for (int j = 0; j < 4; ++j) h.v[j] = (x.v[j] * rs * G.v[j]) * (SC.v[j] + 1.0f) + SH.v[j];
    return h;
}
__device__ __forceinline__ const float* src_row(const Args& a, int row) { const int b = row / RPB, t = row % RPB;
    return t < SEQ ? a.in[0] + ((size_t)b * SEQ + t) * DM : a.in[2] + ((size_t)b * CTXL + (t - SEQ)) * DM; }

template <int MODE>
__device__ __forceinline__ void transpose_item(const float* W, int K, int N, bf16* WT, LAS float* scr, int item, int lane) {
    const int nblk = N / 32, kb = item / nblk, nb = item % nblk, k0 = 64 * kb, n0 = 32 * nb;
#pragma unroll 8
    for (int i = 0; i < 32; ++i) { const int kk = 2 * i + (lane >> 5); scr[kk * 33 + (lane & 31)] = W[(size_t)(k0 + kk) * N + n0 + (lane & 31)]; }
    LDS_WAIT(); asm volatile("" ::: "memory");
    const int c = lane & 7;
#pragma unroll
    for (int j = 0; j < 4; ++j) { const int n = (lane >> 3) + 8 * j; const LAS float* s = scr + (8 * c) * 33 + n;
        u32x4 o; o.x = pk2(s[0 * 33], s[1 * 33]); o.y = pk2(s[2 * 33], s[3 * 33]); o.z = pk2(s[4 * 33], s[5 * 33]); o.w = pk2(s[6 * 33], s[7 * 33]);
        int nn = n0 + n;
        if (MODE == 1) nn = (nn < 1024) ? ((nn >> 2) * 8 + (nn & 3)) : ((((nn - 1024) >> 2) * 8) + 4 + (nn & 3));
        *(u32x4*)(WT + (size_t)nn * K + k0 + 8 * c) = o; }
    LDS_WAIT(); asm volatile("" ::: "memory");
}
__device__ __forceinline__ void mods_item(const float* w_ada, const float* b_ada, float* mods, const LAS float* S, int it, int lane) {
    const int l = it / 384, cc = it % 384, kq = lane >> 4, col = cc * 16 + (lane & 15);
    const float* W = w_ada + (size_t)l * DM * 6144 + col;
    float acc[9];
#pragma unroll
    for (int r = 0; r < 9; ++r) acc[r] = 0.f;
#pragma unroll 8
    for (int kk = 0; kk < 256; ++kk) { const int k = kk * 4 + kq; const float w = W[(size_t)k * 6144];
#pragma unroll
        for (int r = 0; r < 9; ++r) acc[r] += S[r * 1024 + k] * w; }
#pragma unroll
    for (int r = 0; r < 9; ++r) { acc[r] += __shfl_xor(acc[r], 16); acc[r] += __shfl_xor(acc[r], 32); }
    if (lane < 16) { const float bb = b_ada[l * 6144 + col];
#pragma unroll
        for (int r = 0; r < 9; ++r) mods[((size_t)l * 9 + r) * 6144 + col] = acc[r] + bb; }
}
constexpr int I_MOD = 2 * 384, I_QA = 16 * (NQA / 32), I_O = 16 * 32, I_QB = 16 * (NQB / 32), I_W1 = 64 * 1024, I_W2 = 64 * 512;
constexpr int N_ITEMS0 = I_MOD + I_QA + I_O + I_QB + I_O + I_W1 + I_W2;

__device__ __forceinline__ void phase_pro_a(const Args& a, unsigned char* ws, LAS unsigned char* lds, int tid, int lane, int wave, int vcu, int G) {
    LAS float* S = (LAS float*)(lds + 69632);
    for (int i = tid; i < 9 * 1024; i += 512) { const float v = i < 8192 ? a.in[1][i] : a.in[3][i - 8192]; S[i] = v / (1.0f + expf(-v)); }
    __syncthreads();
    LAS float* scr = (LAS float*)(lds + wave * 8448);
    const int gw = vcu * 8 + wave, NGW = G * 8;
    for (int it = gw; it < N_ITEMS0; it += NGW) {
        int r = it;
        if (r < I_MOD) { mods_item(a.in[4], a.in[5], (float*)(ws + WS_MODS), S, r, lane); continue; } r -= I_MOD;
        if (r < I_QA) { transpose_item<0>(a.in[7], DM, NQA, (bf16*)(ws + WS_WQA), scr, r, lane); continue; } r -= I_QA;
        if (r < I_O) { transpose_item<0>(a.in[8], DM, DM, (bf16*)(ws + WS_WOA), scr, r, lane); continue; } r -= I_O;
        if (r < I_QB) { transpose_item<0>(a.in[10], DM, NQB, (bf16*)(ws + WS_WQB), scr, r, lane); continue; } r -= I_QB;
        if (r < I_O) { transpose_item<0>(a.in[13], DM, DM, (bf16*)(ws + WS_WOB), scr, r, lane); continue; } r -= I_O;
        if (r < I_W1) { const int m = r >> 10; transpose_item<1>(a.in[16] + (size_t)m * DM * 2048, DM, 2048, (bf16*)(ws + WS_W1) + (size_t)m * 2048 * DM, scr, r & 1023, lane); continue; } r -= I_W1;
        { const int m = r >> 9; transpose_item<0>(a.in[18] + (size_t)m * DM * DM, DM, DM, (bf16*)(ws + WS_W2) + (size_t)m * DM * DM, scr, r & 511, lane); }
    }
    if (vcu == 0) {
        float* rp = (float*)(ws + WS_ROPE);
        for (int i = tid; i < 1024; i += 512) { const int pos = i >> 4, f = i & 15; const float inv = exp2f(-(float)f * (13.287712379549449f / 16.0f)); const float ang = (float)pos * inv;
            rp[i] = cosf(ang); rp[1024 + i] = sinf(ang); }
        for (int i = tid; i < 2048; i += 512) { const int pos = i >> 5, f = i & 31; const float inv = exp2f(-(float)f * (13.287712379549449f / 32.0f)); const float ang = (float)pos * inv;
            rp[2048 + i] = cosf(ang); rp[4096 + i] = sinf(ang); }
    }
}
__device__ __forceinline__ void phase_pro_b(const Args& a, unsigned char* ws, int lane, int gw, int NGW) {
    const float* mods = (const float*)(ws + WS_MODS); bf16* H = (bf16*)(ws + WS_H);
    for (int row = gw; row < T; row += NGW) {
        const int b = row / RPB, t = row % RPB; const float* mod = mods + (size_t)(t < SEQ ? b : 8) * 6144;
        const Row x = ld_row_f32(src_row(a, row), lane);
        const Row h = norm_mod(x, row_rs(x), a.in[6], mod, mod + 1024, lane);
        st_row_bf16(H + (size_t)row * DM, lane, h);
    }
}
__device__ __forceinline__ void phase_qkfix_a(unsigned char* ws, int gtid, int NGT) {
    bf16* QKV = (bf16*)(ws + WS_QKV); const float* rc = (const float*)(ws + WS_ROPE); const float* rs = rc + 1024;
    for (int f = gtid; f < NB * SEQ * 72; f += NGT) {
        const int sub = f & 3, hd = (f >> 2) % 18, lr = f / 72, b = lr >> 11, t = lr & 2047;
        const int half = sub >> 1, c = (sub & 1) + half * 4, pos = half ? (t & 63) : (t >> 6), f0 = (sub & 1) * 8;
        bf16* p1 = QKV + (size_t)(b * RPB + t) * NQA + hd * 64 + c * 8; bf16* p2 = p1 + 16;
        const u32x4 A = *(const u32x4*)p1, Bv = *(const u32x4*)p2; u32x4 OA, OB;
#pragma unroll
        for (int i = 0; i < 4; ++i) {
            const float cs0 = rc[pos * 16 + f0 + 2 * i], sn0 = rs[pos * 16 + f0 + 2 * i], cs1 = rc[pos * 16 + f0 + 2 * i + 1], sn1 = rs[pos * 16 + f0 + 2 * i + 1];
            const float x10 = bflo(A[i]), x11 = bfhi(A[i]), x20 = bflo(Bv[i]), x21 = bfhi(Bv[i]);
            OA[i] = pk2(x10 * cs0 - x20 * sn0, x11 * cs1 - x21 * sn1); OB[i] = pk2(x20 * cs0 + x10 * sn0, x21 * cs1 + x11 * sn1); }
        *(u32x4*)p1 = OA; *(u32x4*)p2 = OB;
    }
}
__device__ __forceinline__ void phase_qkfix_b(const Args& a, unsigned char* ws, int gtid, int NGT) {
    bf16* QKV = (bf16*)(ws + WS_QKV); const float* rc = (const float*)(ws + WS_ROPE) + 2048; const float* rs = rc + 2048;
    for (int f = gtid; f < T * 80; f += NGT) {
        const int sub = f & 7, hd = (f >> 3) % 10, row = f / 80, t = row % RPB; const bool lat = t < SEQ;
        if (!lat && hd < 8) continue;
        const int half = sub >> 2, c = (sub & 3) + half * 8, pos = half ? (t & 63) : (t >> 6), f0 = (sub & 3) * 8;
        bf16* p1 = QKV + (size_t)row * NQB + hd * 128 + c * 8; bf16* p2 = p1 + 32;
        const u32x4 A = *(const u32x4*)p1, Bv = *(const u32x4*)p2; u32x4 OA, OB;
        float ss = 0.f;
#pragma unroll
        for (int i = 0; i < 4; ++i) { const float x10 = bflo(A[i]), x11 = bfhi(A[i]), x20 = bflo(Bv[i]), x21 = bfhi(Bv[i]); ss += (x10 * x10 + x11 * x11) + (x20 * x20 + x21 * x21); }
        ss += __shfl_xor(ss, 1); ss += __shfl_xor(ss, 2); ss += __shfl_xor(ss, 4);
        const float rn = 1.0f / sqrtf(ss * (1.0f / 128.0f) + EPS);
        const float* gn = (hd < 8 ? a.in[11] : a.in[12]);
#pragma unroll
        for (int i = 0; i < 4; ++i) {
            const int e1 = c * 8 + 2 * i, e2 = e1 + 32;
            const float y10 = bflo(A[i]) * rn * gn[e1], y11 = bfhi(A[i]) * rn * gn[e1 + 1], y20 = bflo(Bv[i]) * rn * gn[e2], y21 = bfhi(Bv[i]) * rn * gn[e2 + 1];
            if (lat) {
                const float cs0 = rc[pos * 32 + f0 + 2 * i], sn0 = rs[pos * 32 + f0 + 2 * i], cs1 = rc[pos * 32 + f0 + 2 * i + 1], sn1 = rs[pos * 32 + f0 + 2 * i + 1];
                OA[i] = pk2(y10 * cs0 - y20 * sn0, y11 * cs1 - y21 * sn1); OB[i] = pk2(y20 * cs0 + y10 * sn0, y21 * cs1 + y11 * sn1);
            } else { OA[i] = pk2(y10, y11); OB[i] = pk2(y20, y21); } }
        *(u32x4*)p1 = OA; *(u32x4*)p2 = OB;
    }
}
__device__ __forceinline__ void phase_attn_a(const Args& a, unsigned char* ws, char* lds, int vcu, int G) {
    const bf16* QKV = (const bf16*)(ws + WS_QKV); bf16* AO = (bf16*)(ws + WS_AO);
    constexpr int NU = NB * 16 * 8 + NB * 16;
    for (int u = vcu; u < NU; u += G) {
        __syncthreads();
        if (u < NB * 128) {
            const int b = u >> 7, h = (u >> 3) & 15, qb = u & 7, g = h >> 3, q0 = qb * 256;
            const int ws0 = q0 >= 128 ? q0 - 128 : 0, we = q0 + 384 < SEQ ? q0 + 384 : SEQ, nwin = (we - ws0) >> 6;
            const bf16* base = QKV + (size_t)b * RPB * NQA;
            att::attn_unit<64, true, NQA>(base + (size_t)q0 * NQA + h * 64, base + 1024 + g * 64, base + 1152 + g * 64, AO + ((size_t)b * RPB + q0) * DM + h * 64,
                                          nwin, ws0, SEQ, nwin + 4, q0, a.in[9][h] * 8.0f, 1.0f, lds);
        } else {
            const int v = u - NB * 128, b = v >> 4, h = v & 15, g = h >> 3;
            const bf16* base = QKV + (size_t)b * RPB * NQA;
            att::attn_unit<64, false, NQA>(base + (size_t)SEQ * NQA + h * 64, base + 1024 + g * 64, base + 1152 + g * 64, AO + ((size_t)b * RPB + SEQ) * DM + h * 64,
                                           0, 0, SEQ, 4, 0, a.in[9][h] * 8.0f, 1.0f, lds);
        }
    }
}
__device__ __forceinline__ void phase_attn_b(unsigned char* ws, char* lds, int vcu, int G) {
    const bf16* QKV = (const bf16*)(ws + WS_QKV); bf16* AO = (bf16*)(ws + WS_AO);
    constexpr int NU = NB * 8 * 8;
    for (int u = vcu; u < NU; u += G) {
        __syncthreads();
        const int b = u >> 6, h = (u >> 3) & 7, qb = u & 7, g = h >> 2, q0 = qb * 256;
        const bf16* base = QKV + (size_t)b * RPB * NQB;
        att::attn_unit<128, false, NQB>(base + (size_t)q0 * NQB + h * 128, base + 1024 + g * 128, base + 1280 + g * 128, AO + ((size_t)b * RPB + q0) * DM + h * 128,
                                        36, 0, 0, 36, q0, -1e30f, 0.0f, lds);
    }
}
__device__ __forceinline__ void phase_tok_b(const Args& a, unsigned char* ws, LAS unsigned char* lds, int l, int tid, int lane, int wave, int gw, int NGW) {
    { const float* wr = a.in[14] + (size_t)l * DM * NE; LAS f32x4* L4 = (LAS f32x4*)lds;
      for (int idx = tid; idx < 8192; idx += 512) { const int c = idx >> 3, q = idx & 7, ln = (c & 255) >> 2, j = c >> 8, i = c & 3;
          L4[((j * 4 + i) * 8 + q) * 64 + ln] = *(const f32x4*)(wr + (size_t)c * 32 + 4 * q); }
      __syncthreads(); }
    const LAS f32x4* L4 = (const LAS f32x4*)lds; LAS float* rsc = (LAS float*)(lds + RSCR_OFF) + wave * 32;
    const float* mods = (const float*)(ws + WS_MODS) + (size_t)l * 9 * 6144; const float* gn = a.in[6] + (size_t)l * 4 * DM;
    const bf16* AP = (const bf16*)(ws + WS_AP); float* XB = (float*)(ws + WS_XB); bf16* H = (bf16*)(ws + WS_H);
    int* cnt = (int*)(ws + WS_CTL) + CW_CNT + l * 32; int* list = (int*)(ws + WS_LIST);
    int* texp = (int*)(ws + WS_RT); int* tpos = (int*)(ws + WS_RT + RT_STRIDE); float* tgate = (float*)(ws + WS_RT + 2 * RT_STRIDE);
    const float* br = a.in[15] + l * NE;
    const int nrows = l == 0 ? T : NB * SEQ;
    for (int r0 = gw; r0 < nrows; r0 += NGW) {
        const int row = l == 0 ? r0 : (r0 >> 11) * RPB + (r0 & 2047);
        const int b = row / RPB, t = row % RPB; const float* mod = mods + (size_t)(t < SEQ ? b : 8) * 6144;
        const Row av = ld_row_bf16(AP + (size_t)row * DM, lane);
        const Row res = ld_row_f32(l == 0 ? src_row(a, row) : XB + (size_t)row * DM, lane);
        const float rs1 = row_rs(av);
        const Row G1 = ld_row_f32(gn + DM, lane), GT = ld_row_f32(mod + 2048, lane); Row x1;
#pragma unroll
        for (int j = 0; j < 4; ++j) x1.v[j] = res.v[j] + GT.v[j] * (av.v[j] * rs1 * G1.v[j]);
        st_row_f32(XB + (size_t)row * DM, lane, x1);
        const Row h2 = norm_mod(x1, row_rs(x1), gn + 2 * DM, mod + 3072, mod + 4096, lane);
        st_row_bf16(H + (size_t)row * DM, lane, h2);
        float acc[32];
#pragma unroll
        for (int e = 0; e < 32; ++e) acc[e] = 0.f;
#pragma unroll
        for (int j = 0; j < 4; ++j)
#pragma unroll
            for (int i = 0; i < 4; ++i) { const float hv = h2.v[j][i];
#pragma unroll
                for (int q = 0; q < 8; ++q) { const f32x4 w = L4[((j * 4 + i) * 8 + q) * 64 + lane];
                    acc[4 * q + 0] += hv * w.x; acc[4 * q + 1] += hv * w.y; acc[4 * q + 2] += hv * w.z; acc[4 * q + 3] += hv * w.w; } }
#define RS_STEP(OFF, N) { const bool up = (lane & (OFF)) != 0; _Pragma("unroll") for (int i = 0; i < (N); ++i) { const float keep = up ? acc[(N) + i] : acc[i], send = up ? acc[i] : acc[(N) + i]; acc[i] = keep + __shfl_xor(send, (OFF)); } }
        RS_STEP(32, 16) RS_STEP(16, 8) RS_STEP(8, 4) RS_STEP(4, 2) RS_STEP(2, 1)
#undef RS_STEP
        float lg = acc[0] + __shfl_xor(acc[0], 1);
        lg += br[lane >> 1];
        if ((lane & 1) == 0) rsc[lane >> 1] = lg;
        LDS_WAIT();
        float v[32];
#pragma unroll
        for (int q = 0; q < 8; ++q) { const f32x4 w = *(const LAS f32x4*)(rsc + 4 * q); v[4 * q] = w.x; v[4 * q + 1] = w.y; v[4 * q + 2] = w.z; v[4 * q + 3] = w.w; }
        unsigned taken = 0u; float tv[4]; int ti[4];
#pragma unroll
        for (int k = 0; k < 4; ++k) { float best = -3.0e38f; int bi = 0;
#pragma unroll
            for (int e = 0; e < 32; ++e) { const bool ok = !((taken >> e) & 1u) && v[e] > best; best = ok ? v[e] : best; bi = ok ? e : bi; }
            taken |= 1u << bi; tv[k] = best; ti[k] = bi; }
        const float e1 = expf(tv[1] - tv[0]), e2 = expf(tv[2] - tv[0]), e3 = expf(tv[3] - tv[0]), inv = 1.0f / (1.0f + e1 + e2 + e3);
        if (lane < 4) {
            const int ek = lane == 0 ? ti[0] : lane == 1 ? ti[1] : lane == 2 ? ti[2] : ti[3];
            const float gk = (lane == 0 ? 1.0f : lane == 1 ? e1 : lane == 2 ? e2 : e3) * inv;
            const int pos = atomicAdd(cnt + ek, 1);
            list[(size_t)ek * CAP + pos] = row; texp[row * 4 + lane] = ek; tpos[row * 4 + lane] = pos; tgate[row * 4 + lane] = gk;
        }
        LDS_WAIT();
    }
}
__device__ __forceinline__ void moe_tables(unsigned char* ws, LAS unsigned char* lds, int l, int tid) {
    LAS int* tab = (LAS int*)(lds + TAB_OFF);
    __syncthreads();
    if (tid == 0) { const int* cnt = (const int*)(ws + WS_CTL) + CW_CNT + l * 32; int tb = 0;
        for (int e = 0; e < 32; ++e) { const int n = __hip_atomic_load(cnt + e, __ATOMIC_RELAXED, __HIP_MEMORY_SCOPE_AGENT); tab[e] = n; tab[32 + e] = tb; tb += (n + 255) >> 8; }
        tab[64] = tb; tab[65] = tb; }
    __syncthreads();
}
__device__ __forceinline__ void phase_tok_c(const Args& a, unsigned char* ws, LAS unsigned char* lds, int l, int lane, int gw, int NGW) {
    const LAS int* tab = (const LAS int*)(lds + TAB_OFF);
    const float* mods = (const float*)(ws + WS_MODS); const float* gn = a.in[6] + (size_t)l * 4 * DM;
    const bf16* Y = (const bf16*)(ws + WS_Y); float* XB = (float*)(ws + WS_XB); bf16* H = (bf16*)(ws + WS_H);
    const i32x4* texp = (const i32x4*)(ws + WS_RT); const i32x4* tpos = (const i32x4*)(ws + WS_RT + RT_STRIDE); const f32x4* tgate = (const f32x4*)(ws + WS_RT + 2 * RT_STRIDE);
    const int nrows = l == 0 ? T : NB * SEQ;
    for (int r0 = gw; r0 < nrows; r0 += NGW) {
        const int row = l == 0 ? r0 : (r0 >> 11) * RPB + (r0 & 2047);
        const int b = row / RPB, t = row % RPB, mr = t < SEQ ? b : 8; const float* mod = mods + ((size_t)l * 9 + mr) * 6144;
        const i32x4 ex = texp[row], ps = tpos[row]; const f32x4 gt = tgate[row];
        Row f;
#pragma unroll
        for (int j = 0; j < 4; ++j) f.v[j] = (f32x4){0.f, 0.f, 0.f, 0.f};
#pragma unroll
        for (int k = 0; k < 4; ++k) { const int srow = tab[32 + ex[k]] * 256 + ps[k]; const Row y = ld_row_bf16(Y + (size_t)srow * DM, lane);
#pragma unroll
            for (int j = 0; j < 4; ++j) f.v[j] += y.v[j] * gt[k]; }
        const float rs = row_rs(f);
        const Row x1 = ld_row_f32(XB + (size_t)row * DM, lane), G3 = ld_row_f32(gn + 3 * DM, lane), GT = ld_row_f32(mod + 5120, lane); Row x2;
#pragma unroll
        for (int j = 0; j < 4; ++j) x2.v[j] = x1.v[j] + GT.v[j] * (f.v[j] * rs * G3.v[j]);
        if (l == 0) {
            st_row_f32(XB + (size_t)row * DM, lane, x2);
            const float* mod1 = mods + ((size_t)9 + mr) * 6144;
            const Row h = norm_mod(x2, row_rs(x2), a.in[6] + 4 * DM, mod1, mod1 + 1024, lane);
            st_row_bf16(H + (size_t)row * DM, lane, h);
        } else {
            st_row_f32(a.out + ((size_t)b * SEQ + t) * DM, lane, x2);
        }
    }
}
__device__ __forceinline__ void phase_dbg_out(const Args& a, unsigned char* ws, int from_x, int lane, int gw, int NGW) {
    const float* XB = (const float*)(ws + WS_XB);
    for (int r0 = gw; r0 < NB * SEQ; r0 += NGW) { const int row = (r0 >> 11) * RPB + (r0 & 2047);
        const Row x = ld_row_f32(from_x ? a.in[0] + (size_t)r0 * DM : XB + (size_t)row * DM, lane); st_row_f32(a.out + (size_t)r0 * DM, lane, x); }
}

constexpr int LAST_PH = DBG_STAGE == 0 ? NPH - 1 : DBG_STAGE == 1 ? -1 : DBG_STAGE == 2 ? 6 : DBG_STAGE == 3 ? 9 : 14;
template <int l>
__device__ __forceinline__ void layer_phases(const Args& args, unsigned char* ws, LAS unsigned char* lds, unsigned char* lds_raw, const XcdBarrier& bar, int lo, int hi,
                                             int tid, int lane, int wave, int G, int bx, int vcu, int gw, int NGW, int gtid, int NGT) {
    constexpr bool ONE = (MK_N_LAUNCHES == 1);
#define IN(k) (lo <= (k) && (k) < hi)
#define SEAM(k) do { if (ONE && IN((k) + 1)) xcd_barrier(bar); } while (0)
        constexpr int P = 2 + 8 * l;
        constexpr int nq = l == 0 ? NQA : NQB;
        if (IN(P) && P <= LAST_PH) {
            pg8::Gemm g{(const pg8::bf16_t*)(ws + WS_H), (const pg8::bf16_t*)(ws + (l == 0 ? WS_WQA : WS_WQB)), T, nq, DM};
            pg8::StaticOrder S; S.init(T, nq, G, bx);
            pg8::EpiStore E{(pg8::bf16_t*)(ws + WS_QKV), nq, nullptr, 0};
            pg8::gemm_phase<pg8::EpiStore, pg8::StaticOrder, true, true, false>(lds, g, S, E);
            SEAM(P);
        }
        if (IN(P + 1) && P + 1 <= LAST_PH) { if (l == 0) phase_qkfix_a(ws, gtid, NGT); else phase_qkfix_b(args, ws, gtid, NGT); SEAM(P + 1); }
        if (IN(P + 2) && P + 2 <= LAST_PH) { if (l == 0) phase_attn_a(args, ws, (char*)lds_raw, vcu, G); else phase_attn_b(ws, (char*)lds_raw, vcu, G); __syncthreads(); SEAM(P + 2); }
        if (IN(P + 3) && P + 3 <= LAST_PH) {
            pg8::Gemm g{(const pg8::bf16_t*)(ws + WS_AO), (const pg8::bf16_t*)(ws + (l == 0 ? WS_WOA : WS_WOB)), T, DM, DM};
            pg8::StaticOrder S; S.init(l == 0 ? T : NB * SEQ, DM, G, bx, l);
            pg8::EpiStore E{(pg8::bf16_t*)(ws + WS_AP), DM, nullptr, 0};
            pg8::gemm_phase<pg8::EpiStore, pg8::StaticOrder, true, true, false>(lds, g, S, E);
            SEAM(P + 3);
        }
        if (IN(P + 4) && P + 4 <= LAST_PH) { phase_tok_b(args, ws, lds, l, tid, lane, wave, gw, NGW); SEAM(P + 4); }
        if (IN(P + 5) && P + 5 <= LAST_PH) {
            moe_tables(ws, lds, l, tid);
            pg8::Gemm g{(const pg8::bf16_t*)(ws + WS_H), (const pg8::bf16_t*)(ws + WS_W1) + (size_t)l * NE * 2048 * DM, T, 2048, DM};
            pg8::MoeOrder S{(const LAS int*)(lds + TAB_OFF), 8, G, vcu, (const int*)(ws + WS_LIST), CAP};
            pg8::EpiSwiglu E{(pg8::bf16_t*)(ws + WS_ACT), args.in[17] + (size_t)l * NE * 2048};
            pg8::gemm_phase<pg8::EpiSwiglu, pg8::MoeOrder, true, true, true>(lds, g, S, E);
            SEAM(P + 5);
        }
        if (IN(P + 6) && P + 6 <= LAST_PH) {
            moe_tables(ws, lds, l, tid);
            pg8::Gemm g{(const pg8::bf16_t*)(ws + WS_ACT), (const pg8::bf16_t*)(ws + WS_W2) + (size_t)l * NE * DM * DM, T, DM, DM};
            pg8::MoeOrder S{(const LAS int*)(lds + TAB_OFF), 4, G, vcu, (const int*)(ws + WS_LIST), CAP};
            pg8::EpiStore E{(pg8::bf16_t*)(ws + WS_Y), DM, args.in[19] + (size_t)l * NE * DM, DM};
            pg8::gemm_phase<pg8::EpiStore, pg8::MoeOrder, true, true, false>(lds, g, S, E);
            SEAM(P + 6);
        }
        if (IN(P + 7) && P + 7 <= LAST_PH) { moe_tables(ws, lds, l, tid); phase_tok_c(args, ws, lds, l, lane, gw, NGW); if (l == 0) SEAM(P + 7); }
    #undef IN
#undef SEAM
}

__global__ void __launch_bounds__(512, 2) fwd(Args args) {
    extern __shared__ __attribute__((aligned(16))) unsigned char lds_raw[];
    LAS unsigned char* lds = (LAS unsigned char*)lds_raw;
    const int tid = threadIdx.x, lane = tid & 63, wave = __builtin_amdgcn_readfirstlane(tid >> 6);
    const int G = gridDim.x, bx = blockIdx.x, vcu = (G % 8 == 0) ? (bx % 8) * (G / 8) + bx / 8 : bx;
    const int gw = vcu * 8 + wave, NGW = G * 8, gtid = vcu * 512 + tid, NGT = G * 512;
    unsigned char* ws = args.ws;
    volatile LAS unsigned* MISC = (volatile LAS unsigned*)(lds + MISC_OFF);
    if (tid < 64) MISC[tid] = 0u;
    __syncthreads();
    constexpr bool ONE = (MK_N_LAUNCHES == 1);
    XcdBarrier bar; bar.bar = (unsigned*)(ws + WS_CTL) + CW_BAR; bar.x = 0; bar.st = nullptr;
    if (ONE) bar = xcd_barrier_post((unsigned*)(ws + WS_CTL) + CW_BAR, MISC + 8);
    const int lo = args.ph_lo, hi = args.ph_hi;
#define IN(k) (lo <= (k) && (k) < hi)
#define SEAM(k) do { if (ONE && IN((k) + 1)) xcd_barrier(bar); } while (0)

    if (IN(0) && 0 <= LAST_PH) { phase_pro_a(args, ws, lds, tid, lane, wave, vcu, G); SEAM(0); }
    if (IN(1) && 1 <= LAST_PH) { phase_pro_b(args, ws, lane, gw, NGW); SEAM(1); }
    layer_phases<0>(args, ws, lds, lds_raw, bar, lo, hi, tid, lane, wave, G, bx, vcu, gw, NGW, gtid, NGT);
    layer_phases<1>(args, ws, lds, lds_raw, bar, lo, hi, tid, lane, wave, G, bx, vcu, gw, NGW, gtid, NGT);
    if (DBG_STAGE != 0 && IN(NPH - 1)) {
        if (ONE) xcd_barrier(bar);
        phase_dbg_out(args, ws, DBG_STAGE == 1, lane, gw, NGW);
    }
#undef IN
#undef SEAM
}

extern "C" void kernel_launch(void* const* d_in, const int* in_sizes, int n_in, void* d_out, int out_size, void* d_ws, size_t ws_size, hipStream_t stream) {
    static int grid = 0;
    if (grid == 0) {
        if (n_in != NIN || in_sizes[0] != NB * SEQ * DM || out_size != NB * SEQ * DM || ws_size < WS_END) {
            fprintf(stderr, "kernel_launch: built for %d inputs, x/out of %d floats, >= %zu bytes of workspace; got n_in %d, in0 %d, out %d, ws %zu; nothing launched\n", NIN, NB * SEQ * DM, (size_t)WS_END, n_in, n_in > 0 ? in_sizes[0] : -1, out_size, ws_size); grid = -1; return; }
        int dev = 0, cus = 0, per_cu = 0;
        if (hipGetDevice(&dev) != hipSuccess || hipDeviceGetAttribute(&cus, hipDeviceAttributeMultiprocessorCount, dev) != hipSuccess) { fprintf(stderr, "kernel_launch: hipGetDevice / hipDeviceGetAttribute failed\n"); grid = -1; return; }
        if (hipFuncSetAttribute((const void*)fwd, hipFuncAttributeMaxDynamicSharedMemorySize, LDS_BYTES) != hipSuccess) { fprintf(stderr, "kernel_launch: hipFuncSetAttribute failed\n"); grid = -1; return; }
        if (hipOccupancyMaxActiveBlocksPerMultiprocessor(&per_cu, (const void*)fwd, 512, LDS_BYTES) != hipSuccess || per_cu < 1)
            fprintf(stderr, "kernel_launch: note: the occupancy query reports %d workgroups per CU\n", per_cu);
        (void)hipGetLastError();
        grid = cus;
    }
    if (grid < 0) return;
    if (hipMemsetAsync((char*)d_ws + WS_CTL, 0, CTL_ZERO_BYTES, stream) != hipSuccess) { fprintf(stderr, "kernel_launch: hipMemsetAsync failed\n"); return; }
    Args a{};
    for (int i = 0; i < NIN; ++i) a.in[i] = (const float*)d_in[i];
    a.out = (float*)d_out; a.ws = (unsigned char*)d_ws;
    for (int li = 0; li < MK_N_LAUNCHES; ++li) {
        a.ph_lo = (MK_N_LAUNCHES == 1) ? 0 : li; a.ph_hi = (MK_N_LAUNCHES == 1) ? NPH : li + 1;
        hipLaunchKernelGGL(fwd, dim3(grid), dim3(512), LDS_BYTES, stream, a);
        const hipError_t le = hipPeekAtLastError();
        if (le != hipSuccess) { fprintf(stderr, "kernel_launch: launch %d failed: %s\n", li, hipGetErrorName(le)); break; }
    }
}
```

```cpp
#include <hip/hip_runtime.h>
#include <cstdio>
#include <cstdint>

#define LAS __attribute__((address_space(3)))
#define GAS __attribute__((address_space(1)))
typedef unsigned short bf16;
typedef short bf16x8 __attribute__((ext_vector_type(8)));
typedef short s16x4 __attribute__((ext_vector_type(4)));
typedef float f32x4 __attribute__((ext_vector_type(4)));
typedef float f32x16 __attribute__((ext_vector_type(16)));
typedef unsigned u32x4 __attribute__((ext_vector_type(4)));
typedef unsigned u32x2 __attribute__((ext_vector_type(2)));
typedef int i32x4 __attribute__((ext_vector_type(4)));

constexpr int NB = 8, SEQ = 2048, CTXL = 256, DM = 1024, RPB = SEQ + CTXL, T = NB * RPB;
constexpr int NQA = 1280, NQB = 1536;
constexpr int NE = 32, TOPK = 4, CAP = T;
constexpr float EPS = 1e-6f;
constexpr int NIN = 20;

#define MK_N_LAUNCHES 1
#define DBG_STAGE 0
#define DUP_MASK 0
namespace pg8 {
#define PG8_LAS __attribute__((address_space(3)))
typedef unsigned short bf16_t;
typedef short bf16x8 __attribute__((ext_vector_type(8)));
typedef float f32x4 __attribute__((ext_vector_type(4)));
typedef unsigned u32x4 __attribute__((ext_vector_type(4)));
typedef int i32x4_t __attribute__((ext_vector_type(4)));
constexpr int BM = 256, BK = 64, HALF = 128, HTB = HALF * BK * 2  , STAGE_BYTES = 8 * HTB, NXCD = 8, WGM = 8;

__host__ __device__ __forceinline__ int lds_byte(int r, int c) { const int st = (r >> 4) * 2 + (c >> 5), rr = r & 15, cc = c & 31, ob = rr * 64 + cc * 2; return st * 1024 + (ob ^ (((ob >> 9) & 1) << 5)); }
__host__ __device__ __forceinline__ void stage_rc(int b, int& R, int& C) { const int st = b / 1024, sb = b % 1024, swz = sb ^ (((sb >> 9) & 1) << 5); R = (st >> 1) * 16 + swz / 64; C = (st & 1) * 32 + (swz % 64) / 2; }
__host__ __device__ __forceinline__ int perm32(int rho) { const int n = rho >> 4, i = rho & 15; return 8 * (i >> 2) + 4 * n + (i & 3); }

struct Unit { int pm, pn, cn, e, pos0, ne; };
struct Gemm { const bf16_t* A; const bf16_t* Bt; int M, N, K; };

struct StaticOrder {
    int nM, nN, nwg, G, c, skip9;
    __host__ __device__ void init(int M, int N, int G_, int c_, int skip9_ = 0) { nM = M / BM; nN = N / BM; nwg = nM * nN; G = G_; c = c_; skip9 = skip9_; }
    __host__ __device__ bool next(int i, Unit& u) const {
        const long L = (long)i * G + c; if (L >= nwg) return false;
        int wgid = (int)L; { const int q = nwg / NXCD, r = nwg % NXCD, xcd = wgid % NXCD, off = wgid / NXCD; wgid = (xcd < r ? xcd * (q + 1) : r * (q + 1) + (xcd - r) * q) + off; }
        const int nig = WGM * nN, gid = wgid / nig, fm = gid * WGM, gsz = (nM - fm) < WGM ? (nM - fm) : WGM;
        u.pm = fm + ((wgid % nig) % gsz); u.pn = (wgid % nig) / gsz; if (skip9) u.pm += u.pm / 8; u.cn = u.pn; u.e = 0; u.pos0 = 0; u.ne = 0; return true;
    }
    __device__ __forceinline__ void a_ready(const Unit&) const {}
    __device__ __forceinline__ void done(const Unit&) const {}
};

template <class Epi, class Sched, bool ALIGN_EPI = false, bool SP2 = false, bool GATHER = false, bool F8 = false>
__device__ __forceinline__ void gemm_phase(PG8_LAS unsigned char* lds, const Gemm g, const Sched& S, const Epi& E) {
    const int tid = threadIdx.x, wid = __builtin_amdgcn_readfirstlane(tid >> 6), lane = tid & 63, wr = wid >> 2, wc = wid & 3, fr = lane & 15, fq = lane >> 4;
    const int K = g.K, nt = K / BK;
    unsigned voffA[2], voffB[2]; int RA[2], CA[2];
#pragma unroll
    for (int i = 0; i < 2; ++i) { int R, C; stage_rc(tid * 16 + i * 8192, R, C); const int Rb = Epi::PERM ? ((R & ~31) + perm32(R & 31)) : R; RA[i] = R; CA[i] = C;
        voffA[i] = (unsigned)(R * K + C) * 2u; voffB[i] = (unsigned)(Rb * K + C) * 2u; }
    unsigned oc0[2], oc1[2], on0[2], on1[2];
#define PG8_GOFF(u, o0, o1) do { _Pragma("unroll") for (int _i = 0; _i < 2; ++_i) { if constexpr (GATHER) { \
        const int lim_ = (u).ne - 1; int p0_ = (u).pos0 + RA[_i], p1_ = p0_ + HALF; p0_ = p0_ < lim_ ? p0_ : lim_; p1_ = p1_ < lim_ ? p1_ : lim_; \
        const int t0_ = S.list[(size_t)(u).e * S.cap + p0_], t1_ = S.list[(size_t)(u).e * S.cap + p1_]; \
        (o0)[_i] = (unsigned)(t0_ * K + CA[_i]) * 2u; (o1)[_i] = (unsigned)(t1_ * K + CA[_i]) * 2u; } else { (o0)[_i] = voffA[_i]; (o1)[_i] = voffA[_i]; } } } while (0)
    const size_t kstep = (size_t)(BK * 2);
    const size_t hstep = (size_t)HALF * K * 2; const size_t hstepA = GATHER ? (size_t)0 : hstep;
    const size_t tstep = 2 * hstep;
    const unsigned ldsw = (unsigned)wid * 1024u;
    const int aoff = lds_byte(wr * 64 + fr, fq * 8), boff = lds_byte(wc * 32 + fr, fq * 8);
#define PG8_SA(b, h) (((b) * 2 + (h)) * HTB)
#define PG8_SB(b, h) ((4 + (b) * 2 + (h)) * HTB)
#define PG8_STAGE(bufoff, gbase, voff) do { _Pragma("unroll") for (int _i = 0; _i < 2; ++_i) \
        __builtin_amdgcn_global_load_lds((const unsigned*)((const char*)(gbase) + (voff)[_i]), (PG8_LAS unsigned*)(lds + (bufoff) + ldsw + _i * 8192), 16, 0, 0); } while (0)
#define PG8_LDA(dst, b, h) do { _Pragma("unroll") for (int m = 0; m < 4; ++m) _Pragma("unroll") for (int k = 0; k < 2; ++k) dst[m][k] = *(const PG8_LAS bf16x8*)(lds + PG8_SA(b, h) + aoff + m * 2048 + k * 1024); } while (0)
#define PG8_LDB(dst, b, h) do { _Pragma("unroll") for (int n = 0; n < 2; ++n) _Pragma("unroll") for (int k = 0; k < 2; ++k) dst[n][k] = *(const PG8_LAS bf16x8*)(lds + PG8_SB(b, h) + boff + n * 2048 + k * 1024); } while (0)
#define PG8_CAT8(x0, x1) __builtin_shufflevector(__builtin_bit_cast(i32x4_t, (x0)), __builtin_bit_cast(i32x4_t, (x1)), 0, 1, 2, 3, 4, 5, 6, 7)
#define PG8_MMA(ai, bj, At, Bt) do { __builtin_amdgcn_s_setprio(1); if constexpr (F8) { _Pragma("unroll") for (int m = 0; m < 4; ++m) _Pragma("unroll") for (int n = 0; n < 2; ++n) \
        asm volatile("s_nop 1\n\tv_mfma_scale_f32_16x16x128_f8f6f4 %0, %1, %2, %0, %3, %3 op_sel_hi:[0,0,0]" : "+v"(acc[ai][bj][m][n]) : "v"(PG8_CAT8(Bt[n][0], Bt[n][1])), "v"(PG8_CAT8(At[m][0], At[m][1])), "v"(0x7f7f7f7f)); } \
    else { _Pragma("unroll") for (int m = 0; m < 4; ++m) _Pragma("unroll") for (int n = 0; n < 2; ++n) _Pragma("unroll") for (int k = 0; k < 2; ++k) \
        acc[ai][bj][m][n] = __builtin_amdgcn_mfma_f32_16x16x32_bf16(Bt[n][k], At[m][k], acc[ai][bj][m][n], 0, 0, 0); } __builtin_amdgcn_s_setprio(0); } while (0)
#define PG8_WAIT_V(n) asm volatile("s_waitcnt vmcnt(" #n ")" ::: "memory")
#define PG8_WAIT_L(n) asm volatile("s_waitcnt lgkmcnt(" #n ")" ::: "memory")
#define PG8_BAR __builtin_amdgcn_s_barrier()
#define PG8_SCHED __builtin_amdgcn_sched_barrier(0)
    Unit cur, nxt; int ui = 0;
    if (!S.next(0, cur)) return;
    f32x4 acc[2][2][4][2];
#pragma unroll
    for (int a = 0; a < 2; ++a)
#pragma unroll
        for (int b = 0; b < 2; ++b)
#pragma unroll
            for (int m = 0; m < 4; ++m)
#pragma unroll
                for (int n = 0; n < 2; ++n) acc[a][b][m][n] = (f32x4){0.f, 0.f, 0.f, 0.f};
    bf16x8 At[4][2], B0[2][2], B1[2][2];
    const char* cA = (const char*)g.A + (GATHER ? (size_t)0 : (size_t)cur.pm * tstep); PG8_GOFF(cur, oc0, oc1); const char* cB = (const char*)g.Bt + (size_t)cur.pn * tstep;
    S.a_ready(cur);
    if constexpr (SP2) {
        PG8_STAGE(PG8_SB(0, 0), cB, voffB); PG8_STAGE(PG8_SB(0, 1), cB + hstep, voffB); PG8_STAGE(PG8_SA(0, 0), cA, oc0); PG8_STAGE(PG8_SA(0, 1), cA + hstepA, oc1);
        if (wr == 1) PG8_BAR;
        PG8_WAIT_V(2); PG8_BAR;
        PG8_STAGE(PG8_SB(1, 0), cB + kstep, voffB); PG8_STAGE(PG8_SA(1, 0), cA + kstep, oc0); PG8_STAGE(PG8_SB(1, 1), cB + hstep + kstep, voffB);
        PG8_WAIT_V(6); PG8_BAR;
    } else {
        PG8_STAGE(PG8_SB(0, 0), cB, voffB); PG8_STAGE(PG8_SA(0, 0), cA, oc0); PG8_STAGE(PG8_SB(0, 1), cB + hstep, voffB); PG8_STAGE(PG8_SA(0, 1), cA + hstepA, oc1);
        if (wr == 1) PG8_BAR;
        PG8_WAIT_V(4); PG8_BAR;
        PG8_STAGE(PG8_SB(1, 0), cB + kstep, voffB); PG8_STAGE(PG8_SA(1, 0), cA + kstep, oc0); PG8_STAGE(PG8_SB(1, 1), cB + hstep + kstep, voffB);
        PG8_WAIT_V(6); PG8_BAR;
    }
    for (;;) {
        const bool has_next = S.next(ui + 1, nxt);
        const char* nA = (has_next && !GATHER) ? (const char*)g.A + (size_t)nxt.pm * tstep : cA;
        if (has_next) { PG8_GOFF(nxt, on0, on1); } else { _Pragma("unroll") for (int _i = 0; _i < 2; ++_i) { on0[_i] = oc0[_i]; on1[_i] = oc1[_i]; } } const char* nB = has_next ? (const char*)g.Bt + (size_t)nxt.pn * tstep : cB;
        for (int t = 0; t < nt; t += 2) {
            const bool last = (t == nt - 2);
            const char* a1 = cA + (size_t)(t + 1) * kstep;
            const char* a2 = last ? nA : cA + (size_t)(t + 2) * kstep; const char* b2 = last ? nB : cB + (size_t)(t + 2) * kstep;
            const char* a3 = a2 + kstep; const char* b3 = b2 + kstep;
            const unsigned s0[2] = {last ? on0[0] : oc0[0], last ? on0[1] : oc0[1]}, s1[2] = {last ? on1[0] : oc1[0], last ? on1[1] : oc1[1]};
            if (last && has_next) S.a_ready(nxt);
            if constexpr (SP2) {
            PG8_LDB(B0, 0, 0); PG8_LDB(B1, 0, 1); PG8_SCHED; PG8_LDA(At, 0, 0); PG8_STAGE(PG8_SA(1, 1), a1 + hstepA, oc1);
            PG8_WAIT_V(8); PG8_WAIT_L(0); PG8_BAR; PG8_MMA(0, 0, At, B0); PG8_MMA(0, 1, At, B1); PG8_BAR; PG8_SCHED;
            PG8_LDA(At, 0, 1); PG8_STAGE(PG8_SB(0, 0), b2, voffB); PG8_STAGE(PG8_SB(0, 1), b2 + hstep, voffB); PG8_STAGE(PG8_SA(0, 0), a2, s0);
            PG8_WAIT_V(8); PG8_WAIT_L(0); PG8_BAR; PG8_MMA(1, 0, At, B0); PG8_MMA(1, 1, At, B1); PG8_BAR; PG8_SCHED;
            PG8_LDB(B0, 1, 0); PG8_LDB(B1, 1, 1); PG8_SCHED; PG8_LDA(At, 1, 0); PG8_STAGE(PG8_SA(0, 1), a2 + hstepA, s1);
            PG8_WAIT_V(8); PG8_WAIT_L(0); PG8_BAR; PG8_MMA(0, 0, At, B0); PG8_MMA(0, 1, At, B1); PG8_BAR; PG8_SCHED;
            PG8_LDA(At, 1, 1); PG8_STAGE(PG8_SB(1, 0), b3, voffB); PG8_STAGE(PG8_SB(1, 1), b3 + hstep, voffB); PG8_STAGE(PG8_SA(1, 0), a3, s0);
            PG8_WAIT_V(8); PG8_WAIT_L(0); PG8_BAR; PG8_MMA(1, 0, At, B0); PG8_MMA(1, 1, At, B1); PG8_BAR; PG8_SCHED;
            } else {
            PG8_LDB(B0, 0, 0); PG8_SCHED; PG8_LDA(At, 0, 0); PG8_STAGE(PG8_SA(1, 1), a1 + hstepA, oc1);
            PG8_WAIT_L(8); PG8_BAR; PG8_WAIT_L(0); PG8_MMA(0, 0, At, B0); PG8_BAR; PG8_SCHED;
            PG8_LDB(B1, 0, 1); PG8_STAGE(PG8_SB(0, 0), b2, voffB);
            PG8_BAR; PG8_WAIT_L(0); PG8_MMA(0, 1, At, B1); PG8_BAR;
            PG8_LDA(At, 0, 1); PG8_STAGE(PG8_SA(0, 0), a2, s0);
            PG8_BAR; PG8_WAIT_L(0); PG8_MMA(1, 0, At, B0); PG8_BAR; PG8_SCHED;
            PG8_STAGE(PG8_SB(0, 1), b2 + hstep, voffB);
            PG8_WAIT_V(6); PG8_BAR; PG8_MMA(1, 1, At, B1); PG8_BAR;
            PG8_LDB(B0, 1, 0); PG8_SCHED; PG8_LDA(At, 1, 0); PG8_STAGE(PG8_SA(0, 1), a2 + hstepA, s1);
            PG8_WAIT_L(8); PG8_BAR; PG8_WAIT_L(0); PG8_MMA(0, 0, At, B0); PG8_BAR; PG8_SCHED;
            PG8_LDB(B1, 1, 1); PG8_STAGE(PG8_SB(1, 0), b3, voffB);
            PG8_BAR; PG8_WAIT_L(0); PG8_MMA(0, 1, At, B1); PG8_BAR;
            PG8_LDA(At, 1, 1); PG8_STAGE(PG8_SA(1, 0), a3, s0);
            PG8_BAR; PG8_WAIT_L(0); PG8_MMA(1, 0, At, B0); PG8_BAR; PG8_SCHED;
            PG8_STAGE(PG8_SB(1, 1), b3 + hstep, voffB);
            PG8_WAIT_V(6); PG8_BAR; PG8_MMA(1, 1, At, B1); PG8_BAR;
            }
        }
        if constexpr (ALIGN_EPI) { if (wr == 0) PG8_BAR; }
        if constexpr (F8) asm volatile("s_nop 15\n\ts_nop 15" ::: "memory");
        if constexpr (!Epi::AFTER_DRAIN) { E(acc, cur, wr, wc, fr, fq); S.done(cur); }
        if (!has_next) break;
#pragma unroll
        for (int a = 0; a < 2; ++a)
#pragma unroll
            for (int b = 0; b < 2; ++b)
#pragma unroll
                for (int m = 0; m < 4; ++m)
#pragma unroll
                    for (int n = 0; n < 2; ++n) acc[a][b][m][n] = (f32x4){0.f, 0.f, 0.f, 0.f};
        cur = nxt; cA = nA; cB = nB; ++ui;
        _Pragma("unroll") for (int _i = 0; _i < 2; ++_i) { oc0[_i] = on0[_i]; oc1[_i] = on1[_i]; }
        if constexpr (ALIGN_EPI) { if (wr == 1) PG8_BAR; }
    }
    PG8_WAIT_V(0);
    if constexpr (!ALIGN_EPI) { if (wr == 0) PG8_BAR; }
    PG8_BAR;
    if constexpr (Epi::AFTER_DRAIN) { E.fused(acc, cur, wr, wc, fr, fq, lds, wid, lane); S.done(cur); }
#undef PG8_GOFF
#undef PG8_CAT8
#undef PG8_SA
#undef PG8_SB
#undef PG8_STAGE
#undef PG8_LDA
#undef PG8_LDB
#undef PG8_MMA
#undef PG8_WAIT_V
#undef PG8_WAIT_L
#undef PG8_BAR
#undef PG8_SCHED
}
}

namespace pg8 {
__device__ __forceinline__ unsigned cvt_pk_bf16(float lo, float hi) { unsigned r; asm volatile("v_cvt_pk_bf16_f32 %0, %1, %2" : "=v"(r) : "v"(lo), "v"(hi)); return r; }
struct EpiStore {
    static constexpr bool PERM = true, AFTER_DRAIN = false;
    bf16_t* O; int ldc; const float* bias; int bias_stride; float ws;
    __device__ __forceinline__ void operator()(const f32x4 (&acc)[2][2][4][2], const Unit& u, int wr, int wc, int fr, int fq) const {
        const int row0 = u.pm * BM + wr * 64 + fr, col0 = u.cn * BM + wc * 32 + 8 * fq;
        f32x4 bv[2][2];
#pragma unroll
        for (int bj = 0; bj < 2; ++bj)
#pragma unroll
            for (int n = 0; n < 2; ++n) bv[bj][n] = bias ? *(const f32x4*)(bias + (size_t)u.e * bias_stride + col0 + bj * HALF + 4 * n) : (f32x4){0.f, 0.f, 0.f, 0.f};
#pragma unroll
        for (int ai = 0; ai < 2; ++ai)
#pragma unroll
            for (int m = 0; m < 4; ++m) { bf16_t* rowp = O + (size_t)(row0 + ai * HALF + m * 16) * ldc + col0;
#pragma unroll
                for (int bj = 0; bj < 2; ++bj) { const f32x4 v0 = acc[ai][bj][m][0] * ws + bv[bj][0], v1 = acc[ai][bj][m][1] * ws + bv[bj][1];
                    u32x4 w; w.x = cvt_pk_bf16(v0[0], v0[1]); w.y = cvt_pk_bf16(v0[2], v0[3]); w.z = cvt_pk_bf16(v1[0], v1[1]); w.w = cvt_pk_bf16(v1[2], v1[3]);
                    *(u32x4*)(rowp + bj * HALF) = w; } }
    }
};
__device__ __forceinline__ unsigned pack4_fp8(float a, float b, float c, float d) { int w = 0; w = __builtin_amdgcn_cvt_pk_fp8_f32(a, b, w, false); w = __builtin_amdgcn_cvt_pk_fp8_f32(c, d, w, true); return (unsigned)w; }
struct EpiSwiglu8 {
    static constexpr bool PERM = true, AFTER_DRAIN = false;
    unsigned char* O; const float* b1; float ws;
    __device__ __forceinline__ void operator()(const f32x4 (&acc)[2][2][4][2], const Unit& u, int wr, int wc, int fr, int fq) const {
        typedef unsigned u32x2v __attribute__((ext_vector_type(2)));
        const int row0 = u.pm * BM + wr * 64 + fr, col0 = u.cn * 128 + wc * 32 + 8 * fq;
        f32x4 bg[2], bl[2];
#pragma unroll
        for (int n = 0; n < 2; ++n) { bg[n] = *(const f32x4*)(b1 + (size_t)u.e * 2048 + col0 + 4 * n); bl[n] = *(const f32x4*)(b1 + (size_t)u.e * 2048 + 1024 + col0 + 4 * n); }
#pragma unroll
        for (int ai = 0; ai < 2; ++ai)
#pragma unroll
            for (int m = 0; m < 4; ++m) { unsigned char* rowp = O + (size_t)(row0 + ai * HALF + m * 16) * 1024 + col0; float a[8];
#pragma unroll
                for (int n = 0; n < 2; ++n) { const f32x4 g = acc[ai][0][m][n] * ws + bg[n], l = acc[ai][1][m][n] * ws + bl[n];
#pragma unroll
                    for (int i = 0; i < 4; ++i) { const float gg = fminf(g[i], 7.0f), ll = fminf(fmaxf(l[i], -7.0f), 7.0f);
                        const float sg = __builtin_amdgcn_rcpf(1.0f + __builtin_amdgcn_exp2f(gg * (-1.702f * 1.4426950408889634f)));
                        a[4 * n + i] = gg * sg * (ll + 1.0f); } }
                u32x2v w; w.x = pack4_fp8(a[0], a[1], a[2], a[3]); w.y = pack4_fp8(a[4], a[5], a[6], a[7]);
                *(u32x2v*)rowp = w; }
    }
};
struct MoeOrder {
    const PG8_LAS int* tab; int nN, G, c; const int* list; int cap;
    __device__ __forceinline__ bool next(int i, Unit& u) const {
        const int L = i * G + c, TT = tab[65]; if (L >= TT * nN) return false;
        int e = 0;
#pragma unroll 4
        for (int k = 1; k < 32; ++k) e += (L >= tab[32 + k] * nN) ? 1 : 0;
        const int t0 = tab[32 + e], mt = tab[33 + e] - t0, local = L - t0 * nN, pml = local % mt, pnl = local / mt;
        u.pm = __builtin_amdgcn_readfirstlane(t0 + pml); u.pn = __builtin_amdgcn_readfirstlane(e * nN + pnl); u.cn = __builtin_amdgcn_readfirstlane(pnl);
        u.e = __builtin_amdgcn_readfirstlane(e); u.pos0 = __builtin_amdgcn_readfirstlane(pml * 256); u.ne = __builtin_amdgcn_readfirstlane(tab[e]); return true;
    }
    __device__ __forceinline__ void a_ready(const Unit&) const {}
    __device__ __forceinline__ void done(const Unit&) const {}
};
}

namespace att {
#define SBAR() __builtin_amdgcn_sched_barrier(0)
constexpr float THR = 8.f;
__device__ __forceinline__ int crow(int r, int hi) { return (r & 3) + 8 * (r >> 2) + 4 * hi; }
__device__ __forceinline__ unsigned cvtpk(float lo, float hi) { unsigned r; asm volatile("v_cvt_pk_bf16_f32 %0, %1, %2" : "=v"(r) : "v"(lo), "v"(hi)); return r; }
template <int D> struct Cst { static constexpr float SCALE = (D == 64) ? 0.125f : 0.088388347648318440f; };
template <int D> __device__ __forceinline__ int kswz(int row, int colB) {
    if constexpr (D == 128) return row * 256 + (colB ^ ((row & 15) << 4));
    else return row * 128 + (colB ^ (((row >> 1) & 7) << 4));
}
template <int D> __device__ __forceinline__ void partialSM(f32x16& p0, f32x16& p1, float& m_reg, float& mn, float& alpha) {
  constexpr float SCALE = Cst<D>::SCALE, C = SCALE * 1.4426950408889634f;
  float pmax = p0[0];
#pragma unroll
  for (int r = 1; r < 16; ++r) pmax = fmaxf(pmax, p0[r]);
#pragma unroll
  for (int r = 0; r < 16; ++r) pmax = fmaxf(pmax, p1[r]);
  { auto rr = __builtin_amdgcn_permlane32_swap(__float_as_uint(pmax), __float_as_uint(pmax), false, false);
    pmax = fmaxf(__uint_as_float(rr[0]), __uint_as_float(rr[1])); }
  if (__builtin_expect(__all(pmax - m_reg <= THR / SCALE), 1)) { mn = m_reg; alpha = 1.f; }
  else { mn = fmaxf(m_reg, pmax); alpha = __builtin_amdgcn_exp2f((m_reg - mn) * C); m_reg = mn; }
  const float mnC = -mn * C;
#pragma unroll
  for (int r = 0; r < 16; ++r) p0[r] = fmaf(p0[r], C, mnC);
#pragma unroll
  for (int r = 0; r < 16; ++r) p1[r] = fmaf(p1[r], C, mnC);
#pragma unroll
  for (int r = 0; r < 16; ++r) p0[r] = __builtin_amdgcn_exp2f(p0[r]);
}
__device__ __forceinline__ void finishSM(f32x16& p0, f32x16& p1, float alpha, float& l_reg, bf16x8& pa0, bf16x8& pa1, bf16x8& pa2, bf16x8& pa3) {
#pragma unroll
  for (int r = 0; r < 16; ++r) p1[r] = __builtin_amdgcn_exp2f(p1[r]);
  float ps = 0;
#pragma unroll
  for (int r = 0; r < 16; ++r) ps += p0[r];
#pragma unroll
  for (int r = 0; r < 16; ++r) ps += p1[r];
  { auto rr = __builtin_amdgcn_permlane32_swap(__float_as_uint(ps), __float_as_uint(ps), false, false);
    ps = __uint_as_float(rr[0]) + __uint_as_float(rr[1]); }
  l_reg = l_reg * alpha + ps;
#define PK4(P, BASE, OUT) do { unsigned a0 = cvtpk(P[BASE + 0], P[BASE + 1]), a1 = cvtpk(P[BASE + 2], P[BASE + 3]);   \
    unsigned b0 = cvtpk(P[BASE + 4], P[BASE + 5]), b1 = cvtpk(P[BASE + 6], P[BASE + 7]);                              \
    auto r0 = __builtin_amdgcn_permlane32_swap(a0, b0, false, false); auto r1 = __builtin_amdgcn_permlane32_swap(a1, b1, false, false); \
    u32x4 w = {r0[0], r1[0], r0[1], r1[1]}; OUT = *reinterpret_cast<bf16x8*>(&w); } while (0)
  PK4(p0, 0, pa0); PK4(p0, 8, pa1); PK4(p1, 0, pa2); PK4(p1, 8, pa3);
#undef PK4
}
__device__ __forceinline__ void wmask(f32x16& p0, f32x16& p1, int dq) {
#pragma unroll
  for (int r = 0; r < 16; ++r) { const int d0 = dq + (r & 3) + 8 * (r >> 2), d1 = d0 + 32;
    if (d0 > 128 || d0 < -128) p0[r] = -1e30f;
    if (d1 > 128 || d1 < -128) p1[r] = -1e30f; }
}
template <int D> __device__ __forceinline__ void qkt(f32x16& p0, f32x16& p1, const char* Ks, const bf16x8* qr, int r32, int hi) {
  p0 = f32x16{}; p1 = f32x16{};
#pragma unroll
  for (int d0 = 0; d0 < D / 16; ++d0) { const int cb = (d0 * 16 + hi * 8) * 2;
    bf16x8 b0 = *reinterpret_cast<const bf16x8*>(Ks + kswz<D>(r32, cb));
    bf16x8 b1 = *reinterpret_cast<const bf16x8*>(Ks + kswz<D>(32 + r32, cb));
    p0 = __builtin_amdgcn_mfma_f32_32x32x16_bf16(b0, qr[d0], p0, 0, 0, 0);
    p1 = __builtin_amdgcn_mfma_f32_32x32x16_bf16(b1, qr[d0], p1, 0, 0, 0); }
}
template <int D> __device__ __forceinline__ int v_st(int k, int c) { const int kk = (k & ~0xC) | ((k & 4) << 1) | ((k & 8) >> 1); return ((kk >> 3) * (D / 32) + (c >> 5)) * 512 + ((kk & 7) * 32 + (c & 31)) * 2; }
__device__ __forceinline__ int v_rd_base(int lane) { return ((lane & 3) << 3) | (((lane >> 2) & 3) << 6) | (((lane >> 4) & 1) << 5) | (((lane >> 5) & 1) << 8); }
template <int D> constexpr int v_rd_off(int d0, int ks, int half) { return ((2 * ks + half) * (D / 32) + d0) * 512; }
template <int OFF> __device__ __forceinline__ s16x4 tr_read(int vb) {
  s16x4 r; asm volatile("ds_read_b64_tr_b16 %0, %1 offset:%2" : "=&v"(r) : "v"(vb), "i"(OFF) : "memory"); return r;
}
template <int D, int D0> __device__ __forceinline__ void pv_one(f32x16& od, int vb, bf16x8 pa0, bf16x8 pa1, bf16x8 pa2, bf16x8 pa3) {
  const s16x4 l0 = tr_read<v_rd_off<D>(D0, 0, 0)>(vb), h0 = tr_read<v_rd_off<D>(D0, 0, 1)>(vb), l1 = tr_read<v_rd_off<D>(D0, 1, 0)>(vb), h1 = tr_read<v_rd_off<D>(D0, 1, 1)>(vb);
  const s16x4 l2 = tr_read<v_rd_off<D>(D0, 2, 0)>(vb), h2 = tr_read<v_rd_off<D>(D0, 2, 1)>(vb), l3 = tr_read<v_rd_off<D>(D0, 3, 0)>(vb), h3 = tr_read<v_rd_off<D>(D0, 3, 1)>(vb);
  asm volatile("s_waitcnt lgkmcnt(0)" ::: "memory"); SBAR();
#define PK(L, H) (bf16x8){L[0], L[1], L[2], L[3], H[0], H[1], H[2], H[3]}
  od = __builtin_amdgcn_mfma_f32_32x32x16_bf16(pa0, PK(l0, h0), od, 0, 0, 0);
  od = __builtin_amdgcn_mfma_f32_32x32x16_bf16(pa1, PK(l1, h1), od, 0, 0, 0);
  od = __builtin_amdgcn_mfma_f32_32x32x16_bf16(pa2, PK(l2, h2), od, 0, 0, 0);
  od = __builtin_amdgcn_mfma_f32_32x32x16_bf16(pa3, PK(l3, h3), od, 0, 0, 0);
#undef PK
}
template <int D> __device__ __forceinline__ void pv_all(f32x16* o, int vb, bf16x8 pa0, bf16x8 pa1, bf16x8 pa2, bf16x8 pa3) {
  pv_one<D, 0>(o[0], vb, pa0, pa1, pa2, pa3); pv_one<D, 1>(o[1], vb, pa0, pa1, pa2, pa3);
  if constexpr (D == 128) { pv_one<D, 2>(o[2], vb, pa0, pa1, pa2, pa3); pv_one<D, 3>(o[3], vb, pa0, pa1, pa2, pa3); }
}
template <int D> constexpr int attn_lds_bytes() { return 4 * 64 * D * 2 + 8 * 64 * 4; }

template <int D, bool MASK, int LD>
__device__ __forceinline__ void attn_unit(const bf16* __restrict__ Qb, const bf16* __restrict__ Kb, const bf16* __restrict__ Vb, bf16* __restrict__ Ob,
                                          int nwin, int wstart, int cstart, int NT, int qpos0, float m0, float l0, char* lds) {
  constexpr int ND0 = D / 16, NDO = D / 32, TPR = D / 8, RPP = 512 / TPR, NP = 64 / RPP, SHM_V = 64 * D * 2, SHM_K = 64 * D * 2, LDO = 1024;
  const int tid = threadIdx.x, wid = tid >> 6, lane = tid & 63, r32 = lane & 31, hi = lane >> 5;
  char* V_lds = lds; char* K_lds = lds + 2 * SHM_V;
  float* ws = (float*)(lds + 2 * SHM_V + 2 * SHM_K) + wid * 64; float* li_l = ws; float* al_l = ws + 32;
  float m_reg = m0, l_reg = l0; f32x16 o[NDO]; bf16x8 qr[ND0];
#pragma unroll
  for (int d = 0; d < NDO; ++d) o[d] = f32x16{};
  const bf16* Qw = Qb + (long)(wid * 32 + r32) * LD + hi * 8;
#pragma unroll
  for (int d0 = 0; d0 < ND0; ++d0) qr[d0] = *reinterpret_cast<const bf16x8*>(Qw + d0 * 16);
  const int sr = tid / TPR, sc = (tid % TPR) * 8;
  int vst[NP], kst[NP];
#pragma unroll
  for (int p = 0; p < NP; ++p) { vst[p] = v_st<D>(sr + p * RPP, sc); kst[p] = kswz<D>(sr + p * RPP, sc * 2); }
  const int vb0 = (int)(uintptr_t)V_lds + v_rd_base(lane);
  const int dqb = 4 * hi - (qpos0 + wid * 32 + r32);
  bf16x8 sv0[NP], sk0[NP], sv1[NP], sk1[NP];
#define KROW(j) ((j) < nwin ? wstart + 64 * (j) : cstart + 64 * ((j) - nwin))
#define SLOAD(SV, SK, j) do { const long rb_ = (long)KROW(j) + sr; _Pragma("unroll") for (int p = 0; p < NP; ++p) { \
    SV[p] = *reinterpret_cast<const bf16x8*>(Vb + (rb_ + p * RPP) * LD + sc); SK[p] = *reinterpret_cast<const bf16x8*>(Kb + (rb_ + p * RPP) * LD + sc); } } while (0)
#define SWRITE(b, SV, SK) do { _Pragma("unroll") for (int p = 0; p < NP; ++p) { *reinterpret_cast<bf16x8*>(V_lds + (b) * SHM_V + vst[p]) = SV[p]; \
    *reinterpret_cast<bf16x8*>(K_lds + (b) * SHM_K + kst[p]) = SK[p]; } } while (0)
#define SWAIT() do { if constexpr (NP == 2) asm volatile("s_waitcnt vmcnt(4)" ::: "memory"); else asm volatile("s_waitcnt vmcnt(2)" ::: "memory"); } while (0)
#define RESC(a) do { if (__any((a) < 1.f)) { if (hi == 0) al_l[r32] = (a); asm volatile("s_waitcnt lgkmcnt(0)" ::: "memory"); \
    _Pragma("unroll") for (int d = 0; d < NDO; ++d) _Pragma("unroll") for (int r = 0; r < 16; ++r) o[d][r] *= al_l[crow(r, hi)]; } } while (0)
#define MASKT(PA, PB, j) do { if constexpr (MASK) { if ((j) < nwin) wmask(PA, PB, wstart + 64 * (j) + dqb); } } while (0)
  f32x16 pA0, pA1, pB0, pB1; float mnA, mnB, alA, alB; bf16x8 pa0, pa1, pa2, pa3;
  SLOAD(sv0, sk0, 0); asm volatile("s_waitcnt vmcnt(0)" ::: "memory"); SWRITE(0, sv0, sk0); __syncthreads();
  qkt<D>(pA0, pA1, K_lds, qr, r32, hi); MASKT(pA0, pA1, 0); partialSM<D>(pA0, pA1, m_reg, mnA, alA);
  SLOAD(sv1, sk1, 1); if (2 < NT) SLOAD(sv0, sk0, 2);
  SWAIT(); SWRITE(1, sv1, sk1); __syncthreads();
  for (int j = 1; j + 1 < NT; j += 2) {
    SBAR(); qkt<D>(pB0, pB1, K_lds + SHM_K, qr, r32, hi);
    finishSM(pA0, pA1, alA, l_reg, pa0, pa1, pa2, pa3); SBAR();
    SLOAD(sv1, sk1, j + 2); SBAR();
    pv_all<D>(o, vb0, pa0, pa1, pa2, pa3); MASKT(pB0, pB1, j); partialSM<D>(pB0, pB1, m_reg, mnB, alB);
    __syncthreads(); SWAIT(); SWRITE(0, sv0, sk0);
    RESC(alB); __syncthreads();
    SBAR(); qkt<D>(pA0, pA1, K_lds, qr, r32, hi);
    finishSM(pB0, pB1, alB, l_reg, pa0, pa1, pa2, pa3); SBAR();
    if (j + 3 < NT) SLOAD(sv0, sk0, j + 3); SBAR();
    pv_all<D>(o, vb0 + SHM_V, pa0, pa1, pa2, pa3); MASKT(pA0, pA1, j + 1); partialSM<D>(pA0, pA1, m_reg, mnA, alA);
    __syncthreads(); SWAIT(); SWRITE(1, sv1, sk1);
    RESC(alA); __syncthreads();
  }
  SBAR(); qkt<D>(pB0, pB1, K_lds + SHM_K, qr, r32, hi);
  finishSM(pA0, pA1, alA, l_reg, pa0, pa1, pa2, pa3); SBAR();
  pv_all<D>(o, vb0, pa0, pa1, pa2, pa3); MASKT(pB0, pB1, NT - 1); partialSM<D>(pB0, pB1, m_reg, mnB, alB);
  __syncthreads(); RESC(alB);
  finishSM(pB0, pB1, alB, l_reg, pa0, pa1, pa2, pa3); SBAR();
  pv_all<D>(o, vb0 + SHM_V, pa0, pa1, pa2, pa3);
  if (hi == 0) li_l[r32] = l_reg; asm volatile("s_waitcnt lgkmcnt(0)" ::: "memory");
  float rli[16];
#pragma unroll
  for (int r = 0; r < 16; ++r) rli[r] = __builtin_amdgcn_rcpf(li_l[crow(r, hi)]);
  bf16* Ow = Ob + (long)(wid * 32) * LDO;
#pragma unroll
  for (int r = 0; r < 16; ++r) { const int orow = crow(r, hi);
#pragma unroll
    for (int d0 = 0; d0 < NDO; ++d0) { const float v = o[d0][r] * rli[r]; Ow[(long)orow * LDO + d0 * 32 + r32] = (bf16)(cvtpk(v, v) & 0xffffu); } }
#undef KROW
#undef SLOAD
#undef SWRITE
#undef SWAIT
#undef RESC
#undef MASKT
}
}

#ifndef MK_N_LAUNCHES
#define MK_N_LAUNCHES 1
#endif
#ifndef DBG_STAGE
#define DBG_STAGE 0
#endif
#ifndef DUP_MASK
#define DUP_MASK 0
#endif
#define NREP(p) ((((DUP_MASK) >> (p)) & 1) ? 2 : 1)
constexpr int NPH = 18;

constexpr size_t MiB = 1u << 20;
constexpr size_t WS_CTL = 0, CTL_ZERO_BYTES = 1 * MiB;
constexpr size_t WS_MODS = 1 * MiB;
constexpr size_t WS_ROPE = WS_MODS + 512 * 1024;
constexpr size_t WS_WQA = 2 * MiB, WS_WOA = 5 * MiB, WS_WQB = 7 * MiB, WS_WOB = 10 * MiB;
constexpr size_t WS_W1 = 16 * MiB;
constexpr size_t WS_W2 = 272 * MiB;
constexpr size_t WS_H8 = 336 * MiB;
constexpr float WSCALE = 32.0f;
constexpr size_t WS_H = 400 * MiB;
constexpr size_t WS_QKV = 436 * MiB;
constexpr size_t WS_AO = 490 * MiB;
constexpr size_t WS_AP = 526 * MiB;
constexpr size_t WS_XB = 562 * MiB;
constexpr size_t WS_RT = 634 * MiB;
constexpr size_t RT_STRIDE = (size_t)T * 4 * 4;
constexpr size_t WS_LIST = 635 * MiB;
constexpr size_t WS_ACT = 638 * MiB;
constexpr size_t WS_Y = 798 * MiB;
constexpr size_t WS_END = 958 * MiB;
static_assert(WS_ROPE + 6144 * 4 <= WS_WQA && WS_WOB + 2 * MiB <= WS_W1 && WS_LIST + (size_t)NE * CAP * 4 <= WS_ACT && WS_RT + 3 * RT_STRIDE <= WS_LIST, "d_ws map");
constexpr int CW_BAR = 4096;
constexpr int CW_CNT = 8192;

constexpr int RING_BYTES = 131072;
constexpr int MISC_OFF = RING_BYTES;
constexpr int TAB_OFF = RING_BYTES + 256;
constexpr int RSCR_OFF = RING_BYTES + 1024;
constexpr int LDS_BYTES = 147456;

#define LDS_WAIT() asm volatile("s_waitcnt lgkmcnt(0)" ::: "memory")
#define VM_WAIT() asm volatile("s_waitcnt vmcnt(0)" ::: "memory")
__device__ __forceinline__ unsigned f2bf(float f) { unsigned u = __builtin_bit_cast(unsigned, f); return (u + 0x7fffu + ((u >> 16) & 1u)) >> 16; }
__device__ __forceinline__ unsigned pk2(float lo, float hi) { return f2bf(lo) | (f2bf(hi) << 16); }
__device__ __forceinline__ float bflo(unsigned w) { return __builtin_bit_cast(float, w << 16); }
__device__ __forceinline__ float bfhi(unsigned w) { return __builtin_bit_cast(float, w & 0xffff0000u); }

#define XB_TMO      128
#define XB_XCNT(j)  (256  + 64 * (j))
#define XB_XSUB(j)  (1280 + 64 * (j))
#define XB_XGEN(j)  (2304 + 64 * (j))
#define XB_TOP      3328
#define XB_TOPGEN   3392
#define XCD_BAR_WORDS 3456
#define XB_SPIN_CAP (1u << 18)

__device__ __forceinline__ unsigned xb_ld(unsigned* p)              { return __hip_atomic_load(p, __ATOMIC_RELAXED, __HIP_MEMORY_SCOPE_AGENT); }
__device__ __forceinline__ unsigned xb_add(unsigned* p, unsigned v) { return __hip_atomic_fetch_add(p, v, __ATOMIC_RELAXED, __HIP_MEMORY_SCOPE_AGENT); }
__device__ __forceinline__ unsigned xb_xcc_id() { return (unsigned)__builtin_amdgcn_s_getreg((3 << 11) | 20) & 0xFu; }
#define XB_SPIN(cond, bar) do { unsigned _sp = 0; while (cond) { __builtin_amdgcn_s_sleep(1); \
    if ((++_sp & 255u) == 0u) { if (xb_ld(&(bar)[XB_TMO])) break; if (_sp > XB_SPIN_CAP) { atomicAdd(&(bar)[XB_TMO], 1u); break; } } } } while (0)

struct XcdBarrier {
    unsigned* bar; unsigned x;
    volatile LAS unsigned* st;
};

__device__ __forceinline__ XcdBarrier xcd_barrier_post(unsigned* bar, volatile LAS unsigned* st) {
    XcdBarrier b; b.bar = bar; b.x = xb_xcc_id(); b.st = st;
    if (threadIdx.x == 0) (void)xb_add(&bar[XB_XCNT(b.x)], 1u);
    return b;
}
__device__ __forceinline__ void xcd_barrier_complete(unsigned* bar, unsigned x, unsigned& nloc, unsigned& nx) {
    const unsigned G = gridDim.x * gridDim.y * gridDim.z;
    unsigned sum, cnt, mine, sp = 0u;
    for (;;) {
        sum = 0u; cnt = 0u; mine = 0u;
#pragma unroll
        for (unsigned j = 0; j < 16; ++j) { const unsigned c = xb_ld(&bar[XB_XCNT(j)]); sum += c; cnt += (c > 0u) ? 1u : 0u; mine = (j == x) ? c : mine; }
        if (sum == G) break;
        __builtin_amdgcn_s_sleep(1);
        if ((++sp & 255u) == 0u) { if (xb_ld(&bar[XB_TMO])) break; if (sp > XB_SPIN_CAP) { atomicAdd(&bar[XB_TMO], 1u); break; } }
    }
    nloc = mine > 0u ? mine : 1u; nx = cnt > 0u ? cnt : 1u;
}

__device__ __forceinline__ void xcd_barrier(const XcdBarrier& b) {
    asm volatile("s_waitcnt vmcnt(0)" ::: "memory");
    __syncthreads();
    if (threadIdx.x == 0) {
        unsigned* bar = b.bar;
        __builtin_amdgcn_s_waitcnt(0);
        unsigned nloc = b.st[0], nx = b.st[1];
        if (nloc == 0u) { xcd_barrier_complete(bar, b.x, nloc, nx); b.st[0] = nloc; b.st[1] = nx; }
        const unsigned old = xb_add(&bar[XB_XSUB(b.x)], 1u);
        const unsigned gen = old / nloc;
        if (old + 1u == (gen + 1u) * nloc) {
            __builtin_amdgcn_fence(__ATOMIC_RELEASE, "agent");
            asm volatile("s_waitcnt vmcnt(0)" ::: "memory");
            const unsigned og = xb_add(&bar[XB_TOP], 1u);
            const unsigned tg = og / nx;
            if (og + 1u == (tg + 1u) * nx) xb_add(&bar[XB_TOPGEN], 1u);
            else XB_SPIN(xb_ld(&bar[XB_TOPGEN]) == tg, bar);
            __builtin_amdgcn_fence(__ATOMIC_ACQUIRE, "agent");
            xb_add(&bar[XB_XGEN(b.x)], 1u);
            asm volatile("s_waitcnt vmcnt(0)" ::: "memory");
        } else {
            XB_SPIN(xb_ld(&bar[XB_XGEN(b.x)]) == gen, bar);
            __builtin_amdgcn_fence(__ATOMIC_ACQUIRE, "agent");
            asm volatile("s_waitcnt vmcnt(0)" ::: "memory");
        }
    }
    __syncthreads();
}

struct Args { const float* in[NIN]; float* out; unsigned char* ws; int ph_lo, ph_hi; };

__device__ __forceinline__ float wave_sum(float v) {
#pragma unroll
    for (int o = 1; o < 64; o <<= 1) v += __shfl_xor(v, o);
    return v;
}
struct Row { f32x4 v[4]; };
__device__ __forceinline__ Row ld_row_f32(const float* p, int lane) { Row r; const f32x4* q = (const f32x4*)p + lane;
#pragma unroll
    for (int j = 0; j < 4; ++j) r.v[j] = q[64 * j];
    return r; }
__device__ __forceinline__ Row ld_row_bf16(const bf16* p, int lane) { Row r; const u32x2* q = (const u32x2*)p + lane;
#pragma unroll
    for (int j = 0; j < 4; ++j) { const u32x2 w = q[64 * j]; r.v[j] = (f32x4){bflo(w.x), bfhi(w.x), bflo(w.y), bfhi(w.y)}; }
    return r; }
__device__ __forceinline__ void st_row_f32(float* p, int lane, const Row& r) { f32x4* q = (f32x4*)p + lane;
#pragma unroll
    for (int j = 0; j < 4; ++j) q[64 * j] = r.v[j]; }
__device__ __forceinline__ void st_row_bf16(bf16* p, int lane, const Row& r) { u32x2* q = (u32x2*)p + lane;
#pragma unroll
    for (int j = 0; j < 4; ++j) { u32x2 w; w.x = pk2(r.v[j].x, r.v[j].y); w.y = pk2(r.v[j].z, r.v[j].w); q[64 * j] = w; } }
__device__ __forceinline__ float row_rs(const Row& r) {
    float s = 0.f;
#pragma unroll
    for (int j = 0; j < 4; ++j) s += (r.v[j].x * r.v[j].x + r.v[j].y * r.v[j].y) + (r.v[j].z * r.v[j].z + r.v[j].w * r.v[j].w);
    return 1.0f / sqrtf(wave_sum(s) * (1.0f / DM) + EPS);
}
__device__ __forceinline__ Row norm_mod(const Row& x, float rs, const float* g, const float* sh, const float* sc, int lane) {
    const Row G = ld_row_f32(g, lane), SH = ld_row_f32(sh, lane), SC = ld_row_f32(sc, lane); Row h;
#pragma unroll
    for (int j = 0; j < 4; ++j) h.v[j] = (x.v[j] * rs * G.v[j]) * (SC.v[j] + 1.0f) + SH.v[j];
    return h;
}
__device__ __forceinline__ const float* src_row(const Args& a, int row) { const int b = row / RPB, t = row % RPB;
    return t < SEQ ? a.in[0] + ((size_t)b * SEQ + t) * DM : a.in[2] + ((size_t)b * CTXL + (t - SEQ)) * DM; }

template <int MODE>
__device__ __forceinline__ void transpose_item(const float* W, int K, int N, bf16* WT, LAS float* scr, int item, int lane) {
    const int nblk = N / 32, kb = item / nblk, nb = item % nblk, k0 = 64 * kb, n0 = 32 * nb;
#pragma unroll 8
    for (int i = 0; i < 32; ++i) { const int kk = 2 * i + (lane >> 5); scr[kk * 33 + (lane & 31)] = W[(size_t)(k0 + kk) * N + n0 + (lane & 31)]; }
    LDS_WAIT(); asm volatile("" ::: "memory");
    const int c = lane & 7;
#pragma unroll
    for (int j = 0; j < 4; ++j) { const int n = (lane >> 3) + 8 * j; const LAS float* s = scr + (8 * c) * 33 + n;
        u32x4 o; o.x = pk2(s[0 * 33], s[1 * 33]); o.y = pk2(s[2 * 33], s[3 * 33]); o.z = pk2(s[4 * 33], s[5 * 33]); o.w = pk2(s[6 * 33], s[7 * 33]);
        *(u32x4*)(WT + (size_t)(n0 + n) * K + k0 + 8 * c) = o; }
    LDS_WAIT(); asm volatile("" ::: "memory");
}
__device__ __forceinline__ unsigned pack4_fp8(float a, float b, float c, float d) { int w = 0; w = __builtin_amdgcn_cvt_pk_fp8_f32(a, b, w, false); w = __builtin_amdgcn_cvt_pk_fp8_f32(c, d, w, true); return (unsigned)w; }
template <int MODE>
__device__ __forceinline__ void transpose_item_f8(const float* W, int K, int N, unsigned char* WT, LAS float* scr, int item, int lane) {
    const int nblk = N / 32, kb = item / nblk, nb = item % nblk, k0 = 64 * kb, n0 = 32 * nb;
#pragma unroll 8
    for (int i = 0; i < 32; ++i) { const int kk = 2 * i + (lane >> 5); scr[kk * 33 + (lane & 31)] = W[(size_t)(k0 + kk) * N + n0 + (lane & 31)] * WSCALE; }
    LDS_WAIT(); asm volatile("" ::: "memory");
    const int c = lane & 3;
#pragma unroll
    for (int j = 0; j < 2; ++j) { const int n = (lane >> 2) + 16 * j; const LAS float* s = scr + (16 * c) * 33 + n;
        u32x4 o; o.x = pack4_fp8(s[0 * 33], s[1 * 33], s[2 * 33], s[3 * 33]); o.y = pack4_fp8(s[4 * 33], s[5 * 33], s[6 * 33], s[7 * 33]);
        o.z = pack4_fp8(s[8 * 33], s[9 * 33], s[10 * 33], s[11 * 33]); o.w = pack4_fp8(s[12 * 33], s[13 * 33], s[14 * 33], s[15 * 33]);
        int nn = n0 + n;
        if (MODE == 1) nn = (nn < 1024) ? ((nn >> 7) * 256 + (nn & 127)) : ((((nn - 1024) >> 7) * 256) + 128 + (nn & 127));
        *(u32x4*)(WT + (size_t)nn * K + k0 + 16 * c) = o; }
    LDS_WAIT(); asm volatile("" ::: "memory");
}
__device__ __forceinline__ void mods_item(const float* w_ada, const float* b_ada, float* mods, const LAS float* S, int it, int lane) {
    const int l = it / 384, cc = it % 384, kq = lane >> 4, col = cc * 16 + (lane & 15);
    const float* W = w_ada + (size_t)l * DM * 6144 + col;
    float acc[9];
#pragma unroll
    for (int r = 0; r < 9; ++r) acc[r] = 0.f;
#pragma unroll 8
    for (int kk = 0; kk < 256; ++kk) { const int k = kk * 4 + kq; const float w = W[(size_t)k * 6144];
#pragma unroll
        for (int r = 0; r < 9; ++r) acc[r] += S[r * 1024 + k] * w; }
#pragma unroll
    for (int r = 0; r < 9; ++r) { acc[r] += __shfl_xor(acc[r], 16); acc[r] += __shfl_xor(acc[r], 32); }
    if (lane < 16) { const float bb = b_ada[l * 6144 + col];
#pragma unroll
        for (int r = 0; r < 9; ++r) mods[((size_t)l * 9 + r) * 6144 + col] = acc[r] + bb; }
}
constexpr int I_MOD = 2 * 384, I_QA = 16 * (NQA / 32), I_O = 16 * 32, I_QB = 16 * (NQB / 32), I_W1 = 64 * 1024, I_W2 = 64 * 512;
constexpr int N_ITEMS0 = I_MOD + I_QA + I_O + I_QB + I_O + I_W1 + I_W2;

__device__ __forceinline__ void phase_pro_a(const Args& a, unsigned char* ws, LAS unsigned char* lds, int tid, int lane, int wave, int vcu, int G) {
    LAS float* S = (LAS float*)(lds + 69632);
    for (int i = tid; i < 9 * 1024; i += 512) { const float v = i < 8192 ? a.in[1][i] : a.in[3][i - 8192]; S[i] = v / (1.0f + expf(-v)); }
    __syncthreads();
    LAS float* scr = (LAS float*)(lds + wave * 8448);
    const int gw = vcu * 8 + wave, NGW = G * 8;
    for (int it = gw; it < N_ITEMS0; it += NGW) {
        int r = it;
        if (r < I_MOD) { mods_item(a.in[4], a.in[5], (float*)(ws + WS_MODS), S, r, lane); continue; } r -= I_MOD;
        if (r < I_QA) { transpose_item<0>(a.in[7], DM, NQA, (bf16*)(ws + WS_WQA), scr, r, lane); continue; } r -= I_QA;
        if (r < I_O) { transpose_item<0>(a.in[8], DM, DM, (bf16*)(ws + WS_WOA), scr, r, lane); continue; } r -= I_O;
        if (r < I_QB) { transpose_item<0>(a.in[10], DM, NQB, (bf16*)(ws + WS_WQB), scr, r, lane); continue; } r -= I_QB;
        if (r < I_O) { transpose_item<0>(a.in[13], DM, DM, (bf16*)(ws + WS_WOB), scr, r, lane); continue; } r -= I_O;
        if (r < I_W1) { const int m = r >> 10; transpose_item_f8<1>(a.in[16] + (size_t)m * DM * 2048, DM, 2048, ws + WS_W1 + (size_t)m * 2048 * DM, scr, r & 1023, lane); continue; } r -= I_W1;
        { const int m = r >> 9; transpose_item_f8<0>(a.in[18] + (size_t)m * DM * DM, DM, DM, ws + WS_W2 + (size_t)m * DM * DM, scr, r & 511, lane); }
    }
    if (vcu == 0) {
        float* rp = (float*)(ws + WS_ROPE);
        for (int i = tid; i < 1024; i += 512) { const int pos = i >> 4, f = i & 15; const float inv = exp2f(-(float)f * (13.287712379549449f / 16.0f)); const float ang = (float)pos * inv;
            rp[i] = cosf(ang); rp[1024 + i] = sinf(ang); }
        for (int i = tid; i < 2048; i += 512) { const int pos = i >> 5, f = i & 31; const float inv = exp2f(-(float)f * (13.287712379549449f / 32.0f)); const float ang = (float)pos * inv;
            rp[2048 + i] = cosf(ang); rp[4096 + i] = sinf(ang); }
    }
}
__device__ __forceinline__ void phase_pro_b(const Args& a, unsigned char* ws, int lane, int gw, int NGW) {
    const float* mods = (const float*)(ws + WS_MODS); bf16* H = (bf16*)(ws + WS_H);
    for (int row = gw; row < T; row += NGW) {
        const int b = row / RPB, t = row % RPB; const float* mod = mods + (size_t)(t < SEQ ? b : 8) * 6144;
        const Row x = ld_row_f32(src_row(a, row), lane);
        const Row h = norm_mod(x, row_rs(x), a.in[6], mod, mod + 1024, lane);
        st_row_bf16(H + (size_t)row * DM, lane, h);
    }
}
__device__ __forceinline__ void phase_qkfix_a(unsigned char* ws, int gtid, int NGT) {
    bf16* QKV = (bf16*)(ws + WS_QKV); const float* rc = (const float*)(ws + WS_ROPE); const float* rs = rc + 1024;
    for (int f = gtid; f < NB * SEQ * 72; f += NGT) {
        const int sub = f & 3, hd = (f >> 2) % 18, lr = f / 72, b = lr >> 11, t = lr & 2047;
        const int half = sub >> 1, c = (sub & 1) + half * 4, pos = half ? (t & 63) : (t >> 6), f0 = (sub & 1) * 8;
        bf16* p1 = QKV + (size_t)(b * RPB + t) * NQA + hd * 64 + c * 8; bf16* p2 = p1 + 16;
        const u32x4 A = *(const u32x4*)p1, Bv = *(const u32x4*)p2; u32x4 OA, OB;
#pragma unroll
        for (int i = 0; i < 4; ++i) {
            const float cs0 = rc[pos * 16 + f0 + 2 * i], sn0 = rs[pos * 16 + f0 + 2 * i], cs1 = rc[pos * 16 + f0 + 2 * i + 1], sn1 = rs[pos * 16 + f0 + 2 * i + 1];
            const float x10 = bflo(A[i]), x11 = bfhi(A[i]), x20 = bflo(Bv[i]), x21 = bfhi(Bv[i]);
            OA[i] = pk2(x10 * cs0 - x20 * sn0, x11 * cs1 - x21 * sn1); OB[i] = pk2(x20 * cs0 + x10 * sn0, x21 * cs1 + x11 * sn1); }
        *(u32x4*)p1 = OA; *(u32x4*)p2 = OB;
    }
}
__device__ __forceinline__ void phase_qkfix_b(const Args& a, unsigned char* ws, int gtid, int NGT) {
    bf16* QKV = (bf16*)(ws + WS_QKV); const float* rc = (const float*)(ws + WS_ROPE) + 2048; const float* rs = rc + 2048;
    for (int f = gtid; f < T * 80; f += NGT) {
        const int sub = f & 7, hd = (f >> 3) % 10, row = f / 80, t = row % RPB; const bool lat = t < SEQ;
        if (!lat && hd < 8) continue;
        const int half = sub >> 2, c = (sub & 3) + half * 8, pos = half ? (t & 63) : (t >> 6), f0 = (sub & 3) * 8;
        bf16* p1 = QKV + (size_t)row * NQB + hd * 128 + c * 8; bf16* p2 = p1 + 32;
        const u32x4 A = *(const u32x4*)p1, Bv = *(const u32x4*)p2; u32x4 OA, OB;
        float ss = 0.f;
#pragma unroll
        for (int i = 0; i < 4; ++i) { const float x10 = bflo(A[i]), x11 = bfhi(A[i]), x20 = bflo(Bv[i]), x21 = bfhi(Bv[i]); ss += (x10 * x10 + x11 * x11) + (x20 * x20 + x21 * x21); }
        ss += __shfl_xor(ss, 1); ss += __shfl_xor(ss, 2); ss += __shfl_xor(ss, 4);
        const float rn = 1.0f / sqrtf(ss * (1.0f / 128.0f) + EPS);
        const float* gn = (hd < 8 ? a.in[11] : a.in[12]);
#pragma unroll
        for (int i = 0; i < 4; ++i) {
            const int e1 = c * 8 + 2 * i, e2 = e1 + 32;
            const float y10 = bflo(A[i]) * rn * gn[e1], y11 = bfhi(A[i]) * rn * gn[e1 + 1], y20 = bflo(Bv[i]) * rn * gn[e2], y21 = bfhi(Bv[i]) * rn * gn[e2 + 1];
            if (lat) {
                const float cs0 = rc[pos * 32 + f0 + 2 * i], sn0 = rs[pos * 32 + f0 + 2 * i], cs1 = rc[pos * 32 + f0 + 2 * i + 1], sn1 = rs[pos * 32 + f0 + 2 * i + 1];
                OA[i] = pk2(y10 * cs0 - y20 * sn0, y11 * cs1 - y21 * sn1); OB[i] = pk2(y20 * cs0 + y10 * sn0, y21 * cs1 + y11 * sn1);
            } else { OA[i] = pk2(y10, y11); OB[i] = pk2(y20, y21); } }
        *(u32x4*)p1 = OA; *(u32x4*)p2 = OB;
    }
}
__device__ __forceinline__ void phase_attn_a(const Args& a, unsigned char* ws, char* lds, int vcu, int G) {
    const bf16* QKV = (const bf16*)(ws + WS_QKV); bf16* AO = (bf16*)(ws + WS_AO);
    constexpr int NU = NB * 16 * 8 + NB * 16;
    for (int u = vcu; u < NU; u += G) {
        __syncthreads();
        if (u < NB * 128) {
            const int b = u >> 7, h = (u >> 3) & 15, qb = u & 7, g = h >> 3, q0 = qb * 256;
            const int ws0 = q0 >= 128 ? q0 - 128 : 0, we = q0 + 384 < SEQ ? q0 + 384 : SEQ, nwin = (we - ws0) >> 6;
            const bf16* base = QKV + (size_t)b * RPB * NQA;
            att::attn_unit<64, true, NQA>(base + (size_t)q0 * NQA + h * 64, base + 1024 + g * 64, base + 1152 + g * 64, AO + ((size_t)b * RPB + q0) * DM + h * 64,
                                          nwin, ws0, SEQ, nwin + 4, q0, a.in[9][h] * 8.0f, 1.0f, lds);
        } else {
            const int v = u - NB * 128, b = v >> 4, h = v & 15, g = h >> 3;
            const bf16* base = QKV + (size_t)b * RPB * NQA;
            att::attn_unit<64, false, NQA>(base + (size_t)SEQ * NQA + h * 64, base + 1024 + g * 64, base + 1152 + g * 64, AO + ((size_t)b * RPB + SEQ) * DM + h * 64,
                                           0, 0, SEQ, 4, 0, a.in[9][h] * 8.0f, 1.0f, lds);
        }
    }
}
__device__ __forceinline__ void phase_attn_b(unsigned char* ws, char* lds, int vcu, int G) {
    const bf16* QKV = (const bf16*)(ws + WS_QKV); bf16* AO = (bf16*)(ws + WS_AO);
    constexpr int NU = NB * 8 * 8;
    for (int u = vcu; u < NU; u += G) {
        __syncthreads();
        const int b = u >> 6, h = (u >> 3) & 7, qb = u & 7, g = h >> 2, q0 = qb * 256;
        const bf16* base = QKV + (size_t)b * RPB * NQB;
        att::attn_unit<128, false, NQB>(base + (size_t)q0 * NQB + h * 128, base + 1024 + g * 128, base + 1280 + g * 128, AO + ((size_t)b * RPB + q0) * DM + h * 128,
                                        36, 0, 0, 36, q0, -1e30f, 0.0f, lds);
    }
}
__device__ __forceinline__ void phase_tok_b(const Args& a, unsigned char* ws, LAS unsigned char* lds, int l, int tid, int lane, int wave, int gw, int NGW, bool dry = false) {
    { const float* wr = a.in[14] + (size_t)l * DM * NE; LAS f32x4* L4 = (LAS f32x4*)lds;
      for (int idx = tid; idx < 8192; idx += 512) { const int c = idx >> 3, q = idx & 7, ln = (c & 255) >> 2, j = c >> 8, i = c & 3;
          L4[((j * 4 + i) * 8 + q) * 64 + ln] = *(const f32x4*)(wr + (size_t)c * 32 + 4 * q); }
      __syncthreads(); }
    const LAS f32x4* L4 = (const LAS f32x4*)lds; LAS float* rsc = (LAS float*)(lds + RSCR_OFF) + wave * 32;
    const float* mods = (const float*)(ws + WS_MODS) + (size_t)l * 9 * 6144; const float* gn = a.in[6] + (size_t)l * 4 * DM;
    const bf16* AP = (const bf16*)(ws + WS_AP); float* XB = (float*)(ws + WS_XB); unsigned char* H8 = ws + WS_H8;
    int* cnt = (int*)(ws + WS_CTL) + CW_CNT + l * 32; int* list = (int*)(ws + WS_LIST);
    int* texp = (int*)(ws + WS_RT); int* tpos = (int*)(ws + WS_RT + RT_STRIDE); float* tgate = (float*)(ws + WS_RT + 2 * RT_STRIDE);
    const float* br = a.in[15] + l * NE;
    const int nrows = l == 0 ? T : NB * SEQ;
    for (int r0 = gw; r0 < nrows; r0 += NGW) {
        const int row = l == 0 ? r0 : (r0 >> 11) * RPB + (r0 & 2047);
        const int b = row / RPB, t = row % RPB; const float* mod = mods + (size_t)(t < SEQ ? b : 8) * 6144;
        const Row av = ld_row_bf16(AP + (size_t)row * DM, lane);
        const Row res = ld_row_f32(l == 0 ? src_row(a, row) : XB + (size_t)row * DM, lane);
        const float rs1 = row_rs(av);
        const Row G1 = ld_row_f32(gn + DM, lane), GT = ld_row_f32(mod + 2048, lane); Row x1;
#pragma unroll
        for (int j = 0; j < 4; ++j) x1.v[j] = res.v[j] + GT.v[j] * (av.v[j] * rs1 * G1.v[j]);
        st_row_f32(XB + (size_t)row * DM, lane, x1);
        const Row h2 = norm_mod(x1, row_rs(x1), gn + 2 * DM, mod + 3072, mod + 4096, lane);
        { unsigned* q8 = (unsigned*)(H8 + (size_t)row * DM) + lane;
#pragma unroll
          for (int j = 0; j < 4; ++j) q8[64 * j] = pack4_fp8(h2.v[j].x, h2.v[j].y, h2.v[j].z, h2.v[j].w); }
        float acc[32];
#pragma unroll
        for (int e = 0; e < 32; ++e) acc[e] = 0.f;
#pragma unroll
        for (int j = 0; j < 4; ++j)
#pragma unroll
            for (int i = 0; i < 4; ++i) { const float hv = h2.v[j][i];
#pragma unroll
                for (int q = 0; q < 8; ++q) { const f32x4 w = L4[((j * 4 + i) * 8 + q) * 64 + lane];
                    acc[4 * q + 0] += hv * w.x; acc[4 * q + 1] += hv * w.y; acc[4 * q + 2] += hv * w.z; acc[4 * q + 3] += hv * w.w; } }
#define RS_STEP(OFF, N) { const bool up = (lane & (OFF)) != 0; _Pragma("unroll") for (int i = 0; i < (N); ++i) { const float keep = up ? acc[(N) + i] : acc[i], send = up ? acc[i] : acc[(N) + i]; acc[i] = keep + __shfl_xor(send, (OFF)); } }
        RS_STEP(32, 16) RS_STEP(16, 8) RS_STEP(8, 4) RS_STEP(4, 2) RS_STEP(2, 1)
#undef RS_STEP
        float lg = acc[0] + __shfl_xor(acc[0], 1);
        lg += br[lane >> 1];
        if ((lane & 1) == 0) rsc[lane >> 1] = lg;
        LDS_WAIT();
        float v[32];
#pragma unroll
        for (int q = 0; q < 8; ++q) { const f32x4 w = *(const LAS f32x4*)(rsc + 4 * q); v[4 * q] = w.x; v[4 * q + 1] = w.y; v[4 * q + 2] = w.z; v[4 * q + 3] = w.w; }
        unsigned taken = 0u; float tv[4]; int ti[4];
#pragma unroll
        for (int k = 0; k < 4; ++k) { float best = -3.0e38f; int bi = 0;
#pragma unroll
            for (int e = 0; e < 32; ++e) { const bool ok = !((taken >> e) & 1u) && v[e] > best; best = ok ? v[e] : best; bi = ok ? e : bi; }
            taken |= 1u << bi; tv[k] = best; ti[k] = bi; }
        const float e1 = expf(tv[1] - tv[0]), e2 = expf(tv[2] - tv[0]), e3 = expf(tv[3] - tv[0]), inv = 1.0f / (1.0f + e1 + e2 + e3);
        if (lane < 4 && !dry) {
            const int ek = lane == 0 ? ti[0] : lane == 1 ? ti[1] : lane == 2 ? ti[2] : ti[3];
            const float gk = (lane == 0 ? 1.0f : lane == 1 ? e1 : lane == 2 ? e2 : e3) * inv;
            const int pos = atomicAdd(cnt + ek, 1);
            list[(size_t)ek * CAP + pos] = row; texp[row * 4 + lane] = ek; tpos[row * 4 + lane] = pos; tgate[row * 4 + lane] = gk;
        }
        LDS_WAIT();
    }
}
__device__ __forceinline__ void moe_tables(unsigned char* ws, LAS unsigned char* lds, int l, int tid) {
    LAS int* tab = (LAS int*)(lds + TAB_OFF);
    __syncthreads();
    if (tid == 0) { const int* cnt = (const int*)(ws + WS_CTL) + CW_CNT + l * 32; int tb = 0;
        for (int e = 0; e < 32; ++e) { const int n = __hip_atomic_load(cnt + e, __ATOMIC_RELAXED, __HIP_MEMORY_SCOPE_AGENT); tab[e] = n; tab[32 + e] = tb; tb += (n + 255) >> 8; }
        tab[64] = tb; tab[65] = tb; }
    __syncthreads();
}
__device__ __forceinline__ void phase_tok_c(const Args& a, unsigned char* ws, LAS unsigned char* lds, int l, int lane, int gw, int NGW) {
    const LAS int* tab = (const LAS int*)(lds + TAB_OFF);
    const float* mods = (const float*)(ws + WS_MODS); const float* gn = a.in[6] + (size_t)l * 4 * DM;
    const bf16* Y = (const bf16*)(ws + WS_Y); float* XB = (float*)(ws + WS_XB); bf16* H = (bf16*)(ws + WS_H);
    const i32x4* texp = (const i32x4*)(ws + WS_RT); const i32x4* tpos = (const i32x4*)(ws + WS_RT + RT_STRIDE); const f32x4* tgate = (const f32x4*)(ws + WS_RT + 2 * RT_STRIDE);
    const int nrows = l == 0 ? T : NB * SEQ;
    for (int r0 = gw; r0 < nrows; r0 += NGW) {
        const int row = l == 0 ? r0 : (r0 >> 11) * RPB + (r0 & 2047);
        const int b = row / RPB, t = row % RPB, mr = t < SEQ ? b : 8; const float* mod = mods + ((size_t)l * 9 + mr) * 6144;
        const i32x4 ex = texp[row], ps = tpos[row]; const f32x4 gt = tgate[row];
        Row f;
#pragma unroll
        for (int j = 0; j < 4; ++j) f.v[j] = (f32x4){0.f, 0.f, 0.f, 0.f};
#pragma unroll
        for (int k = 0; k < 4; ++k) { const int srow = tab[32 + ex[k]] * 256 + ps[k]; const Row y = ld_row_bf16(Y + (size_t)srow * DM, lane);
#pragma unroll
            for (int j = 0; j < 4; ++j) f.v[j] += y.v[j] * gt[k]; }
        const float rs = row_rs(f);
        const Row x1 = ld_row_f32(XB + (size_t)row * DM, lane), G3 = ld_row_f32(gn + 3 * DM, lane), GT = ld_row_f32(mod + 5120, lane); Row x2;
#pragma unroll
        for (int j = 0; j < 4; ++j) x2.v[j] = x1.v[j] + GT.v[j] * (f.v[j] * rs * G3.v[j]);
        if (l == 0) {
            st_row_f32(XB + (size_t)row * DM, lane, x2);
            const float* mod1 = mods + ((size_t)9 + mr) * 6144;
            const Row h = norm_mod(x2, row_rs(x2), a.in[6] + 4 * DM, mod1, mod1 + 1024, lane);
            st_row_bf16(H + (size_t)row * DM, lane, h);
        } else {
            st_row_f32(a.out + ((size_t)b * SEQ + t) * DM, lane, x2);
        }
    }
}
__device__ __forceinline__ void phase_dbg_out(const Args& a, unsigned char* ws, int from_x, int lane, int gw, int NGW) {
    const float* XB = (const float*)(ws + WS_XB);
    for (int r0 = gw; r0 < NB * SEQ; r0 += NGW) { const int row = (r0 >> 11) * RPB + (r0 & 2047);
        const Row x = ld_row_f32(from_x ? a.in[0] + (size_t)r0 * DM : XB + (size_t)row * DM, lane); st_row_f32(a.out + (size_t)r0 * DM, lane, x); }
}

constexpr int LAST_PH = DBG_STAGE == 0 ? NPH - 1 : DBG_STAGE == 1 ? -1 : DBG_STAGE == 2 ? 6 : DBG_STAGE == 3 ? 9 : 14;
template <int l>
__device__ __forceinline__ void layer_phases(const Args& args, unsigned char* ws, LAS unsigned char* lds, unsigned char* lds_raw, const XcdBarrier& bar, int lo, int hi,
                                             int tid, int lane, int wave, int G, int bx, int vcu, int gw, int NGW, int gtid, int NGT) {
    constexpr bool ONE = (MK_N_LAUNCHES == 1);
#define IN(k) (lo <= (k) && (k) < hi)
#define SEAM(k) do { if (ONE && IN((k) + 1)) xcd_barrier(bar); } while (0)
        constexpr int P = 2 + 8 * l;
        constexpr int nq = l == 0 ? NQA : NQB;
        if (IN(P) && P <= LAST_PH) {
            pg8::Gemm g{(const pg8::bf16_t*)(ws + WS_H), (const pg8::bf16_t*)(ws + (l == 0 ? WS_WQA : WS_WQB)), T, nq, DM};
            pg8::StaticOrder S; S.init(T, nq, G, bx);
            pg8::EpiStore E{(pg8::bf16_t*)(ws + WS_QKV), nq, nullptr, 0, 1.0f};
            for (int rep = 0; rep < NREP(P); ++rep) pg8::gemm_phase<pg8::EpiStore, pg8::StaticOrder, true, true, false>(lds, g, S, E);
            SEAM(P);
        }
        if (IN(P + 1) && P + 1 <= LAST_PH) { if (l == 0) phase_qkfix_a(ws, gtid, NGT); else phase_qkfix_b(args, ws, gtid, NGT); SEAM(P + 1); }
        if (IN(P + 2) && P + 2 <= LAST_PH) { for (int rep = 0; rep < NREP(P + 2); ++rep) { if (l == 0) phase_attn_a(args, ws, (char*)lds_raw, vcu, G); else phase_attn_b(ws, (char*)lds_raw, vcu, G); __syncthreads(); } SEAM(P + 2); }
        if (IN(P + 3) && P + 3 <= LAST_PH) {
            pg8::Gemm g{(const pg8::bf16_t*)(ws + WS_AO), (const pg8::bf16_t*)(ws + (l == 0 ? WS_WOA : WS_WOB)), T, DM, DM};
            pg8::StaticOrder S; S.init(l == 0 ? T : NB * SEQ, DM, G, bx, l);
            pg8::EpiStore E{(pg8::bf16_t*)(ws + WS_AP), DM, nullptr, 0, 1.0f};
            for (int rep = 0; rep < NREP(P + 3); ++rep) pg8::gemm_phase<pg8::EpiStore, pg8::StaticOrder, true, true, false>(lds, g, S, E);
            SEAM(P + 3);
        }
        if (IN(P + 4) && P + 4 <= LAST_PH) { phase_tok_b(args, ws, lds, l, tid, lane, wave, gw, NGW); if (l == 0 && NREP(P + 4) == 2) { __syncthreads(); phase_tok_b(args, ws, lds, l, tid, lane, wave, gw, NGW, true); } SEAM(P + 4); }
        if (IN(P + 5) && P + 5 <= LAST_PH) {
            moe_tables(ws, lds, l, tid);
            pg8::Gemm g{(const pg8::bf16_t*)(ws + WS_H8), (const pg8::bf16_t*)(ws + WS_W1 + (size_t)l * NE * 2048 * DM), T, 2048, DM / 2};
            pg8::MoeOrder S{(const LAS int*)(lds + TAB_OFF), 8, G, vcu, (const int*)(ws + WS_LIST), CAP};
            pg8::EpiSwiglu8 E{ws + WS_ACT, args.in[17] + (size_t)l * NE * 2048, 1.0f / WSCALE};
            for (int rep = 0; rep < NREP(P + 5); ++rep) pg8::gemm_phase<pg8::EpiSwiglu8, pg8::MoeOrder, true, true, true, true>(lds, g, S, E);
            SEAM(P + 5);
        }
        if (IN(P + 6) && P + 6 <= LAST_PH) {
            moe_tables(ws, lds, l, tid);
            pg8::Gemm g{(const pg8::bf16_t*)(ws + WS_ACT), (const pg8::bf16_t*)(ws + WS_W2 + (size_t)l * NE * DM * DM), T, DM, DM / 2};
            pg8::MoeOrder S{(const LAS int*)(lds + TAB_OFF), 4, G, vcu, (const int*)(ws + WS_LIST), CAP};
            pg8::EpiStore E{(pg8::bf16_t*)(ws + WS_Y), DM, args.in[19] + (size_t)l * NE * DM, DM, 1.0f / WSCALE};
            for (int rep = 0; rep < NREP(P + 6); ++rep) pg8::gemm_phase<pg8::EpiStore, pg8::MoeOrder, true, true, false, true>(lds, g, S, E);
            SEAM(P + 6);
        }
        if (IN(P + 7) && P + 7 <= LAST_PH) { moe_tables(ws, lds, l, tid); phase_tok_c(args, ws, lds, l, lane, gw, NGW); if (l == 1 && NREP(P + 7) == 2) phase_tok_c(args, ws, lds, l, lane, gw, NGW); if (l == 0) SEAM(P + 7); }
    #undef IN
#undef SEAM
}

__global__ void __launch_bounds__(512, 2) fwd(Args args) {
    extern __shared__ __attribute__((aligned(16))) unsigned char lds_raw[];
    LAS unsigned char* lds = (LAS unsigned char*)lds_raw;
    const int tid = threadIdx.x, lane = tid & 63, wave = __builtin_amdgcn_readfirstlane(tid >> 6);
    const int G = gridDim.x, bx = blockIdx.x, vcu = (G % 8 == 0) ? (bx % 8) * (G / 8) + bx / 8 : bx;
    const int gw = vcu * 8 + wave, NGW = G * 8, gtid = vcu * 512 + tid, NGT = G * 512;
    unsigned char* ws = args.ws;
    volatile LAS unsigned* MISC = (volatile LAS unsigned*)(lds + MISC_OFF);
    if (tid < 64) MISC[tid] = 0u;
    __syncthreads();
    constexpr bool ONE = (MK_N_LAUNCHES == 1);
    XcdBarrier bar; bar.bar = (unsigned*)(ws + WS_CTL) + CW_BAR; bar.x = 0; bar.st = nullptr;
    if (ONE) bar = xcd_barrier_post((unsigned*)(ws + WS_CTL) + CW_BAR, MISC + 8);
    const int lo = args.ph_lo, hi = args.ph_hi;
#define IN(k) (lo <= (k) && (k) < hi)
#define SEAM(k) do { if (ONE && IN((k) + 1)) xcd_barrier(bar); } while (0)

    if (IN(0) && 0 <= LAST_PH) { for (int rep = 0; rep < NREP(0); ++rep) { phase_pro_a(args, ws, lds, tid, lane, wave, vcu, G); __syncthreads(); } SEAM(0); }
    if (IN(1) && 1 <= LAST_PH) { for (int rep = 0; rep < NREP(1); ++rep) phase_pro_b(args, ws, lane, gw, NGW); SEAM(1); }
    layer_phases<0>(args, ws, lds, lds_raw, bar, lo, hi, tid, lane, wave, G, bx, vcu, gw, NGW, gtid, NGT);
    layer_phases<1>(args, ws, lds, lds_raw, bar, lo, hi, tid, lane, wave, G, bx, vcu, gw, NGW, gtid, NGT);
    if (DBG_STAGE != 0 && IN(NPH - 1)) {
        if (ONE) xcd_barrier(bar);
        phase_dbg_out(args, ws, DBG_STAGE == 1, lane, gw, NGW);
    }
#undef IN
#undef SEAM
}

extern "C" void kernel_launch(void* const* d_in, const int* in_sizes, int n_in, void* d_out, int out_size, void* d_ws, size_t ws_size, hipStream_t stream) {
    static int grid = 0;
    if (grid == 0) {
        if (n_in != NIN || in_sizes[0] != NB * SEQ * DM || out_size != NB * SEQ * DM || ws_size < WS_END) {
            fprintf(stderr, "kernel_launch: built for %d inputs, x/out of %d floats, >= %zu bytes of workspace; got n_in %d, in0 %d, out %d, ws %zu; nothing launched\n", NIN, NB * SEQ * DM, (size_t)WS_END, n_in, n_in > 0 ? in_sizes[0] : -1, out_size, ws_size); grid = -1; return; }
        int dev = 0, cus = 0, per_cu = 0;
        if (hipGetDevice(&dev) != hipSuccess || hipDeviceGetAttribute(&cus, hipDeviceAttributeMultiprocessorCount, dev) != hipSuccess) { fprintf(stderr, "kernel_launch: hipGetDevice / hipDeviceGetAttribute failed\n"); grid = -1; return; }
        if (hipFuncSetAttribute((const void*)fwd, hipFuncAttributeMaxDynamicSharedMemorySize, LDS_BYTES) != hipSuccess) { fprintf(stderr, "kernel_launch: hipFuncSetAttribute failed\n"); grid = -1; return; }
        if (hipOccupancyMaxActiveBlocksPerMultiprocessor(&per_cu, (const void*)fwd, 512, LDS_BYTES) != hipSuccess || per_cu < 1)
            fprintf(stderr, "kernel_launch: note: the occupancy query reports %d workgroups per CU\n", per_cu);
        (void)hipGetLastError();
        grid = cus;
    }
    if (grid < 0) return;
    if (hipMemsetAsync((char*)d_ws + WS_CTL, 0, CTL_ZERO_BYTES, stream) != hipSuccess) { fprintf(stderr, "kernel_launch: hipMemsetAsync failed\n"); return; }
    Args a{};
    for (int i = 0; i < NIN; ++i) a.in[i] = (const float*)d_in[i];
    a.out = (float*)d_out; a.ws = (unsigned char*)d_ws;
    for (int li = 0; li < MK_N_LAUNCHES; ++li) {
        a.ph_lo = (MK_N_LAUNCHES == 1) ? 0 : li; a.ph_hi = (MK_N_LAUNCHES == 1) ? NPH : li + 1;
        hipLaunchKernelGGL(fwd, dim3(grid), dim3(512), LDS_BYTES, stream, a);
        const hipError_t le = hipPeekAtLastError();
        if (le != hipSuccess) { fprintf(stderr, "kernel_launch: launch %d failed: %s\n", li, hipGetErrorName(le)); break; }
    }
}
```

```cpp
#include <hip/hip_runtime.h>
#include <cstdio>
#include <cstdint>

#define LAS __attribute__((address_space(3)))
#define GAS __attribute__((address_space(1)))
typedef unsigned short bf16;
typedef short bf16x8 __attribute__((ext_vector_type(8)));
typedef short s16x4 __attribute__((ext_vector_type(4)));
typedef float f32x4 __attribute__((ext_vector_type(4)));
typedef float f32x16 __attribute__((ext_vector_type(16)));
typedef unsigned u32x4 __attribute__((ext_vector_type(4)));
typedef unsigned u32x2 __attribute__((ext_vector_type(2)));
typedef int i32x4 __attribute__((ext_vector_type(4)));

constexpr int NB = 8, SEQ = 2048, CTXL = 256, DM = 1024, RPB = SEQ + CTXL, T = NB * RPB;
constexpr int NQA = 1280, NQB = 1536;
constexpr int NE = 32, TOPK = 4, CAP = T;
constexpr float EPS = 1e-6f;
constexpr int NIN = 20;

#define MK_N_LAUNCHES 1
#define DBG_STAGE 0
#define DUP_MASK 0
#define DBG_PROBE 0
#define DBL_BAR 0
#define SHADOW_MODE 0
#define MODS_WORTH 6
#define STREAM_TEST 0
#define W1_LATE 1
#define W1_FIRST 0
#define TOKB_RPI 3
#define EPI_NULL 0
#define MOE_ALIGN true
#define EARLY_A 3
#define EARLY_B 6
namespace pg8 {
#define PG8_LAS __attribute__((address_space(3)))
typedef unsigned short bf16_t;
typedef short bf16x8 __attribute__((ext_vector_type(8)));
typedef float f32x4 __attribute__((ext_vector_type(4)));
typedef unsigned u32x4 __attribute__((ext_vector_type(4)));
typedef int i32x4_t __attribute__((ext_vector_type(4)));
constexpr int BM = 256, BK = 64, HALF = 128, HTB = HALF * BK * 2  , STAGE_BYTES = 8 * HTB, NXCD = 8, WGM = 8;

__host__ __device__ __forceinline__ int lds_byte(int r, int c) { const int st = (r >> 4) * 2 + (c >> 5), rr = r & 15, cc = c & 31, ob = rr * 64 + cc * 2; return st * 1024 + (ob ^ (((ob >> 9) & 1) << 5)); }
__host__ __device__ __forceinline__ void stage_rc(int b, int& R, int& C) { const int st = b / 1024, sb = b % 1024, swz = sb ^ (((sb >> 9) & 1) << 5); R = (st >> 1) * 16 + swz / 64; C = (st & 1) * 32 + (swz % 64) / 2; }
__host__ __device__ __forceinline__ int perm32(int rho) { const int n = rho >> 4, i = rho & 15; return 8 * (i >> 2) + 4 * n + (i & 3); }

struct Unit { int pm, pn, cn, e, pos0, ne; };
struct Gemm { const bf16_t* A; const bf16_t* Bt; int M, N, K; };

struct StaticOrder {
    int nM, nN, nwg, G, c, skip9;
    __host__ __device__ void init(int M, int N, int G_, int c_, int skip9_ = 0) { nM = M / BM; nN = N / BM; nwg = nM * nN; G = G_; c = c_; skip9 = skip9_; }
    __host__ __device__ bool next(int i, Unit& u) const {
        const long L = (long)i * G + c; if (L >= nwg) return false;
        int wgid = (int)L; { const int q = nwg / NXCD, r = nwg % NXCD, xcd = wgid % NXCD, off = wgid / NXCD; wgid = (xcd < r ? xcd * (q + 1) : r * (q + 1) + (xcd - r) * q) + off; }
        const int nig = WGM * nN, gid = wgid / nig, fm = gid * WGM, gsz = (nM - fm) < WGM ? (nM - fm) : WGM;
        u.pm = fm + ((wgid % nig) % gsz); u.pn = (wgid % nig) / gsz; if (skip9) u.pm += u.pm / 8; u.cn = u.pn; u.e = 0; u.pos0 = 0; u.ne = 0; return true;
    }
    __device__ __forceinline__ void a_ready(const Unit&) const {}
    __device__ __forceinline__ void done(const Unit&) const {}
};

template <class Epi, class Sched, bool ALIGN_EPI = false, bool SP2 = false, bool GATHER = false, bool F8 = false>
__device__ __forceinline__ void gemm_phase(PG8_LAS unsigned char* lds, const Gemm g, const Sched& S, const Epi& E) {
    const int tid = threadIdx.x, wid = __builtin_amdgcn_readfirstlane(tid >> 6), lane = tid & 63, wr = wid >> 2, wc = wid & 3, fr = lane & 15, fq = lane >> 4;
    const int K = g.K, nt = K / BK;
    unsigned voffA[2], voffB[2]; int RA[2], CA[2];
#pragma unroll
    for (int i = 0; i < 2; ++i) { int R, C; stage_rc(tid * 16 + i * 8192, R, C); const int Rb = Epi::PERM ? ((R & ~31) + perm32(R & 31)) : R; RA[i] = R; CA[i] = C;
        voffA[i] = (unsigned)(R * K + C) * 2u; voffB[i] = (unsigned)(Rb * K + C) * 2u; }
    unsigned oc0[2], oc1[2], on0[2], on1[2];
#define PG8_GOFF(u, o0, o1) do { _Pragma("unroll") for (int _i = 0; _i < 2; ++_i) { if constexpr (GATHER) { \
        const int lim_ = (u).ne - 1; int p0_ = (u).pos0 + RA[_i], p1_ = p0_ + HALF; p0_ = p0_ < lim_ ? p0_ : lim_; p1_ = p1_ < lim_ ? p1_ : lim_; \
        const int t0_ = S.list[(size_t)(u).e * S.cap + p0_], t1_ = S.list[(size_t)(u).e * S.cap + p1_]; \
        (o0)[_i] = (unsigned)(t0_ * K + CA[_i]) * 2u; (o1)[_i] = (unsigned)(t1_ * K + CA[_i]) * 2u; } else { (o0)[_i] = voffA[_i]; (o1)[_i] = voffA[_i]; } } } while (0)
    const size_t kstep = (size_t)(BK * 2);
    const size_t hstep = (size_t)HALF * K * 2; const size_t hstepA = GATHER ? (size_t)0 : hstep;
    const size_t tstep = 2 * hstep;
    const unsigned ldsw = (unsigned)wid * 1024u;
    const int aoff = lds_byte(wr * 64 + fr, fq * 8), boff = lds_byte(wc * 32 + fr, fq * 8);
#define PG8_SA(b, h) (((b) * 2 + (h)) * HTB)
#define PG8_SB(b, h) ((4 + (b) * 2 + (h)) * HTB)
#define PG8_STAGE(bufoff, gbase, voff) do { _Pragma("unroll") for (int _i = 0; _i < 2; ++_i) \
        __builtin_amdgcn_global_load_lds((const unsigned*)((const char*)(gbase) + (voff)[_i]), (PG8_LAS unsigned*)(lds + (bufoff) + ldsw + _i * 8192), 16, 0, 0); } while (0)
#define PG8_LDA(dst, b, h) do { _Pragma("unroll") for (int m = 0; m < 4; ++m) _Pragma("unroll") for (int k = 0; k < 2; ++k) dst[m][k] = *(const PG8_LAS bf16x8*)(lds + PG8_SA(b, h) + aoff + m * 2048 + k * 1024); } while (0)
#define PG8_LDB(dst, b, h) do { _Pragma("unroll") for (int n = 0; n < 2; ++n) _Pragma("unroll") for (int k = 0; k < 2; ++k) dst[n][k] = *(const PG8_LAS bf16x8*)(lds + PG8_SB(b, h) + boff + n * 2048 + k * 1024); } while (0)
#define PG8_CAT8(x0, x1) __builtin_shufflevector(__builtin_bit_cast(i32x4_t, (x0)), __builtin_bit_cast(i32x4_t, (x1)), 0, 1, 2, 3, 4, 5, 6, 7)
#define PG8_MMA(ai, bj, At, Bt) do { __builtin_amdgcn_s_setprio(1); if constexpr (F8) { asm volatile("s_nop 1" ::: "memory"); _Pragma("unroll") for (int m = 0; m < 4; ++m) _Pragma("unroll") for (int n = 0; n < 2; ++n) \
        asm volatile("v_mfma_scale_f32_16x16x128_f8f6f4 %0, %1, %2, %0, %3, %3 op_sel_hi:[0,0,0]" : "+v"(acc[ai][bj][m][n]) : "v"(PG8_CAT8(Bt[n][0], Bt[n][1])), "v"(PG8_CAT8(At[m][0], At[m][1])), "v"(0x7f7f7f7f)); } \
    else { _Pragma("unroll") for (int m = 0; m < 4; ++m) _Pragma("unroll") for (int n = 0; n < 2; ++n) _Pragma("unroll") for (int k = 0; k < 2; ++k) \
        acc[ai][bj][m][n] = __builtin_amdgcn_mfma_f32_16x16x32_bf16(Bt[n][k], At[m][k], acc[ai][bj][m][n], 0, 0, 0); } __builtin_amdgcn_s_setprio(0); } while (0)
#define PG8_WAIT_V(n) asm volatile("s_waitcnt vmcnt(" #n ")" ::: "memory")
#define PG8_WAIT_L(n) asm volatile("s_waitcnt lgkmcnt(" #n ")" ::: "memory")
#define PG8_BAR __builtin_amdgcn_s_barrier()
#define PG8_SCHED __builtin_amdgcn_sched_barrier(0)
    Unit cur, nxt; int ui = 0;
    if (!S.next(0, cur)) return;
    f32x4 acc[2][2][4][2];
#pragma unroll
    for (int a = 0; a < 2; ++a)
#pragma unroll
        for (int b = 0; b < 2; ++b)
#pragma unroll
            for (int m = 0; m < 4; ++m)
#pragma unroll
                for (int n = 0; n < 2; ++n) acc[a][b][m][n] = (f32x4){0.f, 0.f, 0.f, 0.f};
    bf16x8 At[4][2], B0[2][2], B1[2][2];
    const char* cA = (const char*)g.A + (GATHER ? (size_t)0 : (size_t)cur.pm * tstep); PG8_GOFF(cur, oc0, oc1); const char* cB = (const char*)g.Bt + (size_t)cur.pn * tstep;
    S.a_ready(cur);
    if constexpr (SP2) {
        PG8_STAGE(PG8_SB(0, 0), cB, voffB); PG8_STAGE(PG8_SB(0, 1), cB + hstep, voffB); PG8_STAGE(PG8_SA(0, 0), cA, oc0); PG8_STAGE(PG8_SA(0, 1), cA + hstepA, oc1);
        if (wr == 1) PG8_BAR;
        PG8_WAIT_V(2); PG8_BAR;
        PG8_STAGE(PG8_SB(1, 0), cB + kstep, voffB); PG8_STAGE(PG8_SA(1, 0), cA + kstep, oc0); PG8_STAGE(PG8_SB(1, 1), cB + hstep + kstep, voffB);
        PG8_WAIT_V(6); PG8_BAR;
    } else {
        PG8_STAGE(PG8_SB(0, 0), cB, voffB); PG8_STAGE(PG8_SA(0, 0), cA, oc0); PG8_STAGE(PG8_SB(0, 1), cB + hstep, voffB); PG8_STAGE(PG8_SA(0, 1), cA + hstepA, oc1);
        if (wr == 1) PG8_BAR;
        PG8_WAIT_V(4); PG8_BAR;
        PG8_STAGE(PG8_SB(1, 0), cB + kstep, voffB); PG8_STAGE(PG8_SA(1, 0), cA + kstep, oc0); PG8_STAGE(PG8_SB(1, 1), cB + hstep + kstep, voffB);
        PG8_WAIT_V(6); PG8_BAR;
    }
    for (;;) {
        E.stage(lds + 132096 + (ui & 1) * 1024, cur, wid, lane);
        const bool has_next = S.next(ui + 1, nxt);
        const char* nA = (has_next && !GATHER) ? (const char*)g.A + (size_t)nxt.pm * tstep : cA;
        if constexpr (GATHER) { if (has_next && wid < 4) { const int lim_ = nxt.ne - 1; int p_ = nxt.pos0 + wid * 64 + lane; p_ = p_ < lim_ ? p_ : lim_; __builtin_amdgcn_global_load_lds((const unsigned*)(S.list + (size_t)nxt.e * S.cap + p_), (PG8_LAS unsigned*)(lds + 134144 + wid * 256), 4, 0, 0); } } const char* nB = has_next ? (const char*)g.Bt + (size_t)nxt.pn * tstep : cB;
        for (int t = 0; t < nt; t += 2) {
            const bool last = (t == nt - 2);
            const char* a1 = cA + (size_t)(t + 1) * kstep;
            const char* a2 = last ? nA : cA + (size_t)(t + 2) * kstep; const char* b2 = last ? nB : cB + (size_t)(t + 2) * kstep;
            const char* a3 = a2 + kstep; const char* b3 = b2 + kstep;
            if (last) { _Pragma("unroll") for (int _i = 0; _i < 2; ++_i) { if (GATHER && has_next) { const volatile PG8_LAS int* ids_ = (const volatile PG8_LAS int*)(lds + 134144); const int t0_ = ids_[RA[_i]], t1_ = ids_[RA[_i] + HALF]; on0[_i] = (unsigned)(t0_ * K + CA[_i]) * 2u; on1[_i] = (unsigned)(t1_ * K + CA[_i]) * 2u; } else { on0[_i] = oc0[_i]; on1[_i] = oc1[_i]; } } }
            const unsigned s0[2] = {last ? on0[0] : oc0[0], last ? on0[1] : oc0[1]}, s1[2] = {last ? on1[0] : oc1[0], last ? on1[1] : oc1[1]};
            if (last && has_next) S.a_ready(nxt);
            if constexpr (SP2) {
            PG8_LDB(B0, 0, 0); PG8_LDB(B1, 0, 1); PG8_SCHED; PG8_LDA(At, 0, 0); PG8_STAGE(PG8_SA(1, 1), a1 + hstepA, oc1);
            PG8_WAIT_V(8); PG8_WAIT_L(0); PG8_BAR; PG8_MMA(0, 0, At, B0); PG8_MMA(0, 1, At, B1); PG8_BAR; PG8_SCHED;
            PG8_LDA(At, 0, 1); PG8_STAGE(PG8_SB(0, 0), b2, voffB); PG8_STAGE(PG8_SB(0, 1), b2 + hstep, voffB); PG8_STAGE(PG8_SA(0, 0), a2, s0);
            PG8_WAIT_V(8); PG8_WAIT_L(0); PG8_BAR; PG8_MMA(1, 0, At, B0); PG8_MMA(1, 1, At, B1); PG8_BAR; PG8_SCHED;
            PG8_LDB(B0, 1, 0); PG8_LDB(B1, 1, 1); PG8_SCHED; PG8_LDA(At, 1, 0); PG8_STAGE(PG8_SA(0, 1), a2 + hstepA, s1);
            PG8_WAIT_V(8); PG8_WAIT_L(0); PG8_BAR; PG8_MMA(0, 0, At, B0); PG8_MMA(0, 1, At, B1); PG8_BAR; PG8_SCHED;
            PG8_LDA(At, 1, 1); PG8_STAGE(PG8_SB(1, 0), b3, voffB); PG8_STAGE(PG8_SB(1, 1), b3 + hstep, voffB); PG8_STAGE(PG8_SA(1, 0), a3, s0);
            PG8_WAIT_V(8); PG8_WAIT_L(0); PG8_BAR; PG8_MMA(1, 0, At, B0); PG8_MMA(1, 1, At, B1); PG8_BAR; PG8_SCHED;
            } else {
            PG8_LDB(B0, 0, 0); PG8_SCHED; PG8_LDA(At, 0, 0); PG8_STAGE(PG8_SA(1, 1), a1 + hstepA, oc1);
            PG8_WAIT_L(8); PG8_BAR; PG8_WAIT_L(0); PG8_MMA(0, 0, At, B0); PG8_BAR; PG8_SCHED;
            PG8_LDB(B1, 0, 1); PG8_STAGE(PG8_SB(0, 0), b2, voffB);
            PG8_BAR; PG8_WAIT_L(0); PG8_MMA(0, 1, At, B1); PG8_BAR;
            PG8_LDA(At, 0, 1); PG8_STAGE(PG8_SA(0, 0), a2, s0);
            PG8_BAR; PG8_WAIT_L(0); PG8_MMA(1, 0, At, B0); PG8_BAR; PG8_SCHED;
            PG8_STAGE(PG8_SB(0, 1), b2 + hstep, voffB);
            PG8_WAIT_V(6); PG8_BAR; PG8_MMA(1, 1, At, B1); PG8_BAR;
            PG8_LDB(B0, 1, 0); PG8_SCHED; PG8_LDA(At, 1, 0); PG8_STAGE(PG8_SA(0, 1), a2 + hstepA, s1);
            PG8_WAIT_L(8); PG8_BAR; PG8_WAIT_L(0); PG8_MMA(0, 0, At, B0); PG8_BAR; PG8_SCHED;
            PG8_LDB(B1, 1, 1); PG8_STAGE(PG8_SB(1, 0), b3, voffB);
            PG8_BAR; PG8_WAIT_L(0); PG8_MMA(0, 1, At, B1); PG8_BAR;
            PG8_LDA(At, 1, 1); PG8_STAGE(PG8_SA(1, 0), a3, s0);
            PG8_BAR; PG8_WAIT_L(0); PG8_MMA(1, 0, At, B0); PG8_BAR; PG8_SCHED;
            PG8_STAGE(PG8_SB(1, 1), b3 + hstep, voffB);
            PG8_WAIT_V(6); PG8_BAR; PG8_MMA(1, 1, At, B1); PG8_BAR;
            }
        }
        if constexpr (ALIGN_EPI) { if (wr == 0) PG8_BAR; }
        if constexpr (F8) asm volatile("s_nop 15\n\ts_nop 15" ::: "memory");
        if constexpr (!Epi::AFTER_DRAIN) { E(acc, cur, wr, wc, fr, fq, (const PG8_LAS float*)(lds + 132096 + (ui & 1) * 1024)); S.done(cur); }
        if (!has_next) break;
#pragma unroll
        for (int a = 0; a < 2; ++a)
#pragma unroll
            for (int b = 0; b < 2; ++b)
#pragma unroll
                for (int m = 0; m < 4; ++m)
#pragma unroll
                    for (int n = 0; n < 2; ++n) acc[a][b][m][n] = (f32x4){0.f, 0.f, 0.f, 0.f};
        cur = nxt; cA = nA; cB = nB; ++ui;
        _Pragma("unroll") for (int _i = 0; _i < 2; ++_i) { oc0[_i] = on0[_i]; oc1[_i] = on1[_i]; }
        if constexpr (ALIGN_EPI) { if (wr == 1) PG8_BAR; }
    }
    PG8_WAIT_V(0);
    if constexpr (!ALIGN_EPI) { if (wr == 0) PG8_BAR; }
    PG8_BAR;
    if constexpr (Epi::AFTER_DRAIN) { E.fused(acc, cur, wr, wc, fr, fq, lds, wid, lane); S.done(cur); }
#undef PG8_GOFF
#undef PG8_CAT8
#undef PG8_SA
#undef PG8_SB
#undef PG8_STAGE
#undef PG8_LDA
#undef PG8_LDB
#undef PG8_MMA
#undef PG8_WAIT_V
#undef PG8_WAIT_L
#undef PG8_BAR
#undef PG8_SCHED
}
}

namespace pg8 {
__device__ __forceinline__ unsigned cvt_pk_bf16(float lo, float hi) { unsigned r; asm volatile("v_cvt_pk_bf16_f32 %0, %1, %2" : "=v"(r) : "v"(lo), "v"(hi)); return r; }
struct EpiStore {
    static constexpr bool PERM = true, AFTER_DRAIN = false;
    bf16_t* O; int ldc; const float* bias; int bias_stride; float ws;
    __device__ __forceinline__ void stage(PG8_LAS unsigned char*, const Unit&, int, int) const {}
    __device__ __forceinline__ void operator()(const f32x4 (&acc)[2][2][4][2], const Unit& u, int wr, int wc, int fr, int fq, const PG8_LAS float* lb) const {
        const int row0 = u.pm * BM + wr * 64 + fr, col0 = u.cn * BM + wc * 32 + 8 * fq;
        f32x4 bv[2][2];
#pragma unroll
        for (int bj = 0; bj < 2; ++bj)
#pragma unroll
            for (int n = 0; n < 2; ++n) bv[bj][n] = bias ? *(const f32x4*)(bias + (size_t)u.e * bias_stride + col0 + bj * HALF + 4 * n) : (f32x4){0.f, 0.f, 0.f, 0.f};
#pragma unroll
        for (int ai = 0; ai < 2; ++ai)
#pragma unroll
            for (int m = 0; m < 4; ++m) { bf16_t* rowp = O + (size_t)(row0 + ai * HALF + m * 16) * ldc + col0;
#pragma unroll
                for (int bj = 0; bj < 2; ++bj) { const f32x4 v0 = acc[ai][bj][m][0] * ws + bv[bj][0], v1 = acc[ai][bj][m][1] * ws + bv[bj][1];
                    u32x4 w; w.x = cvt_pk_bf16(v0[0], v0[1]); w.y = cvt_pk_bf16(v0[2], v0[3]); w.z = cvt_pk_bf16(v1[0], v1[1]); w.w = cvt_pk_bf16(v1[2], v1[3]);
                    *(u32x4*)(rowp + bj * HALF) = w; } }
    }
};
struct EpiRopeA {
    static constexpr bool PERM = true, AFTER_DRAIN = false;
    bf16_t* O; const float* rc; const float* rs;
    __device__ __forceinline__ void stage(PG8_LAS unsigned char*, const Unit&, int, int) const {}
    __device__ __forceinline__ void operator()(const f32x4 (&acc)[2][2][4][2], const Unit& u, int wr, int wc, int fr, int fq, const PG8_LAS float* lb) const {
        typedef unsigned u32x2v __attribute__((ext_vector_type(2)));
        const int row0 = u.pm * BM + wr * 64 + fr, vcol0 = u.cn * BM + wc * 32 + 8 * fq;
        const bool lat = (u.pm % 9) != 8;
#pragma unroll
        for (int ai = 0; ai < 2; ++ai)
#pragma unroll
            for (int m = 0; m < 4; ++m) { const int row = row0 + ai * HALF + m * 16, t = row % 2304, pos = (wc & 1) ? (t & 63) : ((t >> 6) & 31);
                const f32x4 cs = *(const f32x4*)(rc + pos * 16 + 4 * fq), sn = *(const f32x4*)(rs + pos * 16 + 4 * fq);
                bf16_t* rowp = O + (size_t)row * 1280;
#pragma unroll
                for (int bj = 0; bj < 2; ++bj) { const f32x4 v0 = acc[ai][bj][m][0], v1 = acc[ai][bj][m][1]; const int vc = vcol0 + bj * HALF;
                    if (u.cn < 4 || bj == 0) { const f32x4 o1 = lat ? v0 * cs - v1 * sn : v0, o2 = lat ? v1 * cs + v0 * sn : v1; const int a1 = (vc & ~63) + (wc & 1) * 32 + 4 * fq;
                        u32x2v w1, w2; w1.x = cvt_pk_bf16(o1[0], o1[1]); w1.y = cvt_pk_bf16(o1[2], o1[3]); w2.x = cvt_pk_bf16(o2[0], o2[1]); w2.y = cvt_pk_bf16(o2[2], o2[3]);
                        *(u32x2v*)(rowp + a1) = w1; *(u32x2v*)(rowp + a1 + 16) = w2; }
                    else { u32x4 w; w.x = cvt_pk_bf16(v0[0], v0[1]); w.y = cvt_pk_bf16(v0[2], v0[3]); w.z = cvt_pk_bf16(v1[0], v1[1]); w.w = cvt_pk_bf16(v1[2], v1[3]); *(u32x4*)(rowp + vc) = w; } } }
    }
};
__device__ __forceinline__ unsigned pack4_fp8(float a, float b, float c, float d) { int w = 0; w = __builtin_amdgcn_cvt_pk_fp8_f32(a, b, w, false); w = __builtin_amdgcn_cvt_pk_fp8_f32(c, d, w, true); return (unsigned)w; }
struct EpiStore8 {
    static constexpr bool PERM = true, AFTER_DRAIN = false;
    unsigned char* O; int ldc; const float* bias; int bias_stride; float ws;
    __device__ __forceinline__ void stage(PG8_LAS unsigned char* lb, const Unit& u, int wid, int lane) const {
        if (wid < 4) __builtin_amdgcn_global_load_lds((const unsigned*)(bias + (size_t)u.e * bias_stride + u.cn * BM + wid * 64 + lane), (PG8_LAS unsigned*)(lb + wid * 256), 4, 0, 0); }
    __device__ __forceinline__ void operator()(const f32x4 (&acc)[2][2][4][2], const Unit& u, int wr, int wc, int fr, int fq, const PG8_LAS float* lb) const {
        typedef unsigned u32x2v __attribute__((ext_vector_type(2)));
        const int row0 = u.pm * BM + wr * 64 + fr, col0 = u.cn * BM + wc * 32 + 8 * fq;
        f32x4 bv[2][2];
#pragma unroll
        for (int bj = 0; bj < 2; ++bj)
#pragma unroll
            for (int n = 0; n < 2; ++n) bv[bj][n] = *(const PG8_LAS f32x4*)(lb + bj * HALF + wc * 32 + 8 * fq + 4 * n);
#pragma unroll
        for (int ai = 0; ai < 2; ++ai)
#pragma unroll
            for (int m = 0; m < 4; ++m) { unsigned char* rowp = O + (size_t)(row0 + ai * HALF + m * 16) * ldc + col0;
#pragma unroll
                for (int bj = 0; bj < 2; ++bj) { const f32x4 v0 = acc[ai][bj][m][0] * ws + bv[bj][0], v1 = acc[ai][bj][m][1] * ws + bv[bj][1];
                    u32x2v w; w.x = pack4_fp8(v0[0], v0[1], v0[2], v0[3]); w.y = pack4_fp8(v1[0], v1[1], v1[2], v1[3]);
                    *(u32x2v*)(rowp + bj * HALF) = w; } }
    }
};
struct EpiSwiglu8 {
    static constexpr bool PERM = true, AFTER_DRAIN = false;
    unsigned char* O; const float* b1; float ws;
    __device__ __forceinline__ void stage(PG8_LAS unsigned char* lb, const Unit& u, int wid, int lane) const {
        if (wid < 4) __builtin_amdgcn_global_load_lds((const unsigned*)(b1 + (size_t)u.e * 2048 + (wid >> 1) * 1024 + u.cn * 128 + (wid & 1) * 64 + lane), (PG8_LAS unsigned*)(lb + wid * 256), 4, 0, 0); }
    __device__ __forceinline__ void operator()(const f32x4 (&acc)[2][2][4][2], const Unit& u, int wr, int wc, int fr, int fq, const PG8_LAS float* lb) const {
        typedef unsigned u32x2v __attribute__((ext_vector_type(2)));
        const int row0 = u.pm * BM + wr * 64 + fr, col0 = u.cn * 128 + wc * 32 + 8 * fq;
        f32x4 bg[2], bl[2];
#pragma unroll
        for (int n = 0; n < 2; ++n) { bg[n] = *(const PG8_LAS f32x4*)(lb + wc * 32 + 8 * fq + 4 * n); bl[n] = *(const PG8_LAS f32x4*)(lb + 128 + wc * 32 + 8 * fq + 4 * n); }
#pragma unroll
        for (int ai = 0; ai < 2; ++ai)
#pragma unroll
            for (int m = 0; m < 4; ++m) { unsigned char* rowp = O + (size_t)(row0 + ai * HALF + m * 16) * 1024 + col0; float a[8];
#pragma unroll
                for (int n = 0; n < 2; ++n) { const f32x4 g = acc[ai][0][m][n] * ws + bg[n], l = acc[ai][1][m][n] * ws + bl[n];
#pragma unroll
                    for (int i = 0; i < 4; ++i) { const float gg = fminf(g[i], 7.0f), ll = fminf(fmaxf(l[i], -7.0f), 7.0f);
                        const float sg = __builtin_amdgcn_rcpf(1.0f + __builtin_amdgcn_exp2f(gg * (-1.702f * 1.4426950408889634f)));
                        a[4 * n + i] = gg * sg * (ll + 1.0f); } }
                u32x2v w; w.x = pack4_fp8(a[0], a[1], a[2], a[3]); w.y = pack4_fp8(a[4], a[5], a[6], a[7]);
                *(u32x2v*)rowp = w; }
    }
};
struct EpiNull {
    static constexpr bool PERM = true, AFTER_DRAIN = false;
    __device__ __forceinline__ void stage(PG8_LAS unsigned char*, const Unit&, int, int) const {}
    __device__ __forceinline__ void operator()(const f32x4 (&acc)[2][2][4][2], const Unit& u, int wr, int wc, int fr, int fq, const PG8_LAS float* lb) const {
#pragma unroll
        for (int ai = 0; ai < 2; ++ai)
#pragma unroll
            for (int m = 0; m < 4; ++m) asm volatile("" :: "v"(acc[ai][0][m][0]), "v"(acc[ai][1][m][1]), "v"(acc[ai][0][m][1]), "v"(acc[ai][1][m][0])); }
};
struct MoeOrder {
    const PG8_LAS int* tab; int nN, G, c; const int* list; int cap; int same;
    __device__ __forceinline__ bool next(int i, Unit& u) const {
        int L = i * G + c; const int TT = tab[65]; if (L >= TT * nN) return false;
        if (same) L = 0;
        const int lk = (int)(threadIdx.x & 31);
        const int e = __builtin_popcountll(__ballot(lk >= 1 && L >= tab[32 + lk] * nN) & 0xffffffffull);
        const int t0 = tab[32 + e], mt = tab[33 + e] - t0, local = L - t0 * nN, pml = local % mt, pnl = local / mt;
        u.pm = __builtin_amdgcn_readfirstlane(t0 + pml); u.pn = __builtin_amdgcn_readfirstlane(e * nN + pnl); u.cn = __builtin_amdgcn_readfirstlane(pnl);
        u.e = __builtin_amdgcn_readfirstlane(e); u.pos0 = __builtin_amdgcn_readfirstlane(pml * 256); u.ne = __builtin_amdgcn_readfirstlane(tab[e]); return true;
    }
    __device__ __forceinline__ void a_ready(const Unit&) const {}
    __device__ __forceinline__ void done(const Unit&) const {}
};
}

namespace att {
#define SBAR() __builtin_amdgcn_sched_barrier(0)
constexpr float THR = 8.f;
__device__ __forceinline__ int crow(int r, int hi) { return (r & 3) + 8 * (r >> 2) + 4 * hi; }
__device__ __forceinline__ unsigned cvtpk(float lo, float hi) { unsigned r; asm volatile("v_cvt_pk_bf16_f32 %0, %1, %2" : "=v"(r) : "v"(lo), "v"(hi)); return r; }
template <int D> struct Cst { static constexpr float SCALE = (D == 64) ? 0.125f : 0.088388347648318440f; };
template <int D> __device__ __forceinline__ int kswz(int row, int colB) {
    if constexpr (D == 128) return row * 256 + (colB ^ ((row & 15) << 4));
    else return row * 128 + (colB ^ (((row >> 1) & 7) << 4));
}
template <int D> __device__ __forceinline__ void partialSM(f32x16& p0, f32x16& p1, float& m_reg, float& mn, float& alpha) {
  constexpr float SCALE = Cst<D>::SCALE, C = SCALE * 1.4426950408889634f;
  float pmax = p0[0];
#pragma unroll
  for (int r = 1; r < 16; ++r) pmax = fmaxf(pmax, p0[r]);
#pragma unroll
  for (int r = 0; r < 16; ++r) pmax = fmaxf(pmax, p1[r]);
  { auto rr = __builtin_amdgcn_permlane32_swap(__float_as_uint(pmax), __float_as_uint(pmax), false, false);
    pmax = fmaxf(__uint_as_float(rr[0]), __uint_as_float(rr[1])); }
  if (__builtin_expect(__all(pmax - m_reg <= THR / SCALE), 1)) { mn = m_reg; alpha = 1.f; }
  else { mn = fmaxf(m_reg, pmax); alpha = __builtin_amdgcn_exp2f((m_reg - mn) * C); m_reg = mn; }
  const float mnC = -mn * C;
#pragma unroll
  for (int r = 0; r < 16; ++r) p0[r] = fmaf(p0[r], C, mnC);
#pragma unroll
  for (int r = 0; r < 16; ++r) p1[r] = fmaf(p1[r], C, mnC);
#pragma unroll
  for (int r = 0; r < 16; ++r) p0[r] = __builtin_amdgcn_exp2f(p0[r]);
}
__device__ __forceinline__ void finishSM(f32x16& p0, f32x16& p1, float alpha, float& l_reg, bf16x8& pa0, bf16x8& pa1, bf16x8& pa2, bf16x8& pa3) {
#pragma unroll
  for (int r = 0; r < 16; ++r) p1[r] = __builtin_amdgcn_exp2f(p1[r]);
  float ps = 0;
#pragma unroll
  for (int r = 0; r < 16; ++r) ps += p0[r];
#pragma unroll
  for (int r = 0; r < 16; ++r) ps += p1[r];
  { auto rr = __builtin_amdgcn_permlane32_swap(__float_as_uint(ps), __float_as_uint(ps), false, false);
    ps = __uint_as_float(rr[0]) + __uint_as_float(rr[1]); }
  l_reg = l_reg * alpha + ps;
#define PK4(P, BASE, OUT) do { unsigned a0 = cvtpk(P[BASE + 0], P[BASE + 1]), a1 = cvtpk(P[BASE + 2], P[BASE + 3]);   \
    unsigned b0 = cvtpk(P[BASE + 4], P[BASE + 5]), b1 = cvtpk(P[BASE + 6], P[BASE + 7]);                              \
    auto r0 = __builtin_amdgcn_permlane32_swap(a0, b0, false, false); auto r1 = __builtin_amdgcn_permlane32_swap(a1, b1, false, false); \
    u32x4 w = {r0[0], r1[0], r0[1], r1[1]}; OUT = *reinterpret_cast<bf16x8*>(&w); } while (0)
  PK4(p0, 0, pa0); PK4(p0, 8, pa1); PK4(p1, 0, pa2); PK4(p1, 8, pa3);
#undef PK4
}
__device__ __forceinline__ void wmask(f32x16& p0, f32x16& p1, int dq) {
#pragma unroll
  for (int r = 0; r < 16; ++r) { const int d0 = dq + (r & 3) + 8 * (r >> 2), d1 = d0 + 32;
    if (d0 > 128 || d0 < -128) p0[r] = -1e30f;
    if (d1 > 128 || d1 < -128) p1[r] = -1e30f; }
}
template <int D> __device__ __forceinline__ void qkt(f32x16& p0, f32x16& p1, const char* Ks, const bf16x8* qr, int r32, int hi) {
  p0 = f32x16{}; p1 = f32x16{};
#pragma unroll
  for (int d0 = 0; d0 < D / 16; ++d0) { const int cb = (d0 * 16 + hi * 8) * 2;
    bf16x8 b0 = *reinterpret_cast<const bf16x8*>(Ks + kswz<D>(r32, cb));
    bf16x8 b1 = *reinterpret_cast<const bf16x8*>(Ks + kswz<D>(32 + r32, cb));
    p0 = __builtin_amdgcn_mfma_f32_32x32x16_bf16(b0, qr[d0], p0, 0, 0, 0);
    p1 = __builtin_amdgcn_mfma_f32_32x32x16_bf16(b1, qr[d0], p1, 0, 0, 0); }
}
template <int D> __device__ __forceinline__ int v_st(int k, int c) { const int kk = (k & ~0xC) | ((k & 4) << 1) | ((k & 8) >> 1); return ((kk >> 3) * (D / 32) + (c >> 5)) * 512 + ((kk & 7) * 32 + (c & 31)) * 2; }
__device__ __forceinline__ int v_rd_base(int lane) { return ((lane & 3) << 3) | (((lane >> 2) & 3) << 6) | (((lane >> 4) & 1) << 5) | (((lane >> 5) & 1) << 8); }
template <int D> constexpr int v_rd_off(int d0, int ks, int half) { return ((2 * ks + half) * (D / 32) + d0) * 512; }
template <int OFF> __device__ __forceinline__ s16x4 tr_read(int vb) {
  s16x4 r; asm volatile("ds_read_b64_tr_b16 %0, %1 offset:%2" : "=&v"(r) : "v"(vb), "i"(OFF) : "memory"); return r;
}
template <int D, int D0> __device__ __forceinline__ void pv_one(f32x16& od, int vb, bf16x8 pa0, bf16x8 pa1, bf16x8 pa2, bf16x8 pa3) {
  const s16x4 l0 = tr_read<v_rd_off<D>(D0, 0, 0)>(vb), h0 = tr_read<v_rd_off<D>(D0, 0, 1)>(vb), l1 = tr_read<v_rd_off<D>(D0, 1, 0)>(vb), h1 = tr_read<v_rd_off<D>(D0, 1, 1)>(vb);
  const s16x4 l2 = tr_read<v_rd_off<D>(D0, 2, 0)>(vb), h2 = tr_read<v_rd_off<D>(D0, 2, 1)>(vb), l3 = tr_read<v_rd_off<D>(D0, 3, 0)>(vb), h3 = tr_read<v_rd_off<D>(D0, 3, 1)>(vb);
  asm volatile("s_waitcnt lgkmcnt(0)" ::: "memory"); SBAR();
#define PK(L, H) (bf16x8){L[0], L[1], L[2], L[3], H[0], H[1], H[2], H[3]}
  od = __builtin_amdgcn_mfma_f32_32x32x16_bf16(pa0, PK(l0, h0), od, 0, 0, 0);
  od = __builtin_amdgcn_mfma_f32_32x32x16_bf16(pa1, PK(l1, h1), od, 0, 0, 0);
  od = __builtin_amdgcn_mfma_f32_32x32x16_bf16(pa2, PK(l2, h2), od, 0, 0, 0);
  od = __builtin_amdgcn_mfma_f32_32x32x16_bf16(pa3, PK(l3, h3), od, 0, 0, 0);
#undef PK
}
template <int D> __device__ __forceinline__ void pv_all(f32x16* o, int vb, bf16x8 pa0, bf16x8 pa1, bf16x8 pa2, bf16x8 pa3) {
  pv_one<D, 0>(o[0], vb, pa0, pa1, pa2, pa3); pv_one<D, 1>(o[1], vb, pa0, pa1, pa2, pa3);
  if constexpr (D == 128) { pv_one<D, 2>(o[2], vb, pa0, pa1, pa2, pa3); pv_one<D, 3>(o[3], vb, pa0, pa1, pa2, pa3); }
}
template <int D> constexpr int attn_lds_bytes() { return 4 * 64 * D * 2 + 8 * 64 * 4; }

template <int D, bool MASK, int LD, bool QFIX = false>
__device__ __forceinline__ void attn_unit(const bf16* __restrict__ Qb, const bf16* __restrict__ Kb, const bf16* __restrict__ Vb, bf16* __restrict__ Ob,
                                          int nwin, int wstart, int cstart, int NT, int qpos0, float m0, float l0, char* lds,
                                          const float* qaux = nullptr) {
  constexpr int ND0 = D / 16, NDO = D / 32, TPR = D / 8, RPP = 512 / TPR, NP = 64 / RPP, SHM_V = 64 * D * 2, SHM_K = 64 * D * 2, LDO = 1024;
  const int tid = threadIdx.x, wid = tid >> 6, lane = tid & 63, r32 = lane & 31, hi = lane >> 5;
  char* V_lds = lds; char* K_lds = lds + 2 * SHM_V;
  float* ws = (float*)(lds + 2 * SHM_V + 2 * SHM_K) + wid * 64; float* li_l = ws; float* al_l = ws + 32;
  float m_reg = m0, l_reg = l0; f32x16 o[NDO]; bf16x8 qr[ND0];
#pragma unroll
  for (int d = 0; d < NDO; ++d) o[d] = f32x16{};
  const bf16* Qw = Qb + (long)(wid * 32 + r32) * LD + hi * 8;
#pragma unroll
  for (int d0 = 0; d0 < ND0; ++d0) qr[d0] = *reinterpret_cast<const bf16x8*>(Qw + d0 * 16);
  if constexpr (QFIX) {
    static_assert(D == 128, "QFIX is the mixer-B (head dim 128) path");
    const float* rcos = qaux; const float* rsin = qaux + 2048; const float* qgain = qaux + 4096;
    float ss = 0.f;
#pragma unroll
    for (int d0 = 0; d0 < 8; ++d0)
#pragma unroll
      for (int j = 0; j < 8; ++j) { const float v = __builtin_bit_cast(float, (unsigned)(unsigned short)qr[d0][j] << 16); ss += v * v; }
    { auto rr = __builtin_amdgcn_permlane32_swap(__float_as_uint(ss), __float_as_uint(ss), false, false); ss = __uint_as_float(rr[0]) + __uint_as_float(rr[1]); }
    const float rn = 1.0f / sqrtf(ss * (1.0f / 128.0f) + 1e-6f);
    const int tq = qpos0 + wid * 32 + r32;
#pragma unroll
    for (int hf = 0; hf < 2; ++hf) { const int pos = hf ? (tq & 63) : ((tq >> 6) & 31);
#pragma unroll
      for (int dd = 0; dd < 2; ++dd) { const int d1 = hf * 4 + dd, d2 = d1 + 2, f0 = dd * 16 + hi * 8;
        float cs[8], sn[8], g1[8], g2[8];
#pragma unroll
        for (int q = 0; q < 2; ++q) { const f32x4 c = *(const f32x4*)(rcos + pos * 32 + f0 + 4 * q), z = *(const f32x4*)(rsin + pos * 32 + f0 + 4 * q);
          const f32x4 a = *(const f32x4*)(qgain + d1 * 16 + hi * 8 + 4 * q), b = *(const f32x4*)(qgain + d2 * 16 + hi * 8 + 4 * q);
#pragma unroll
          for (int j = 0; j < 4; ++j) { cs[4 * q + j] = c[j]; sn[4 * q + j] = z[j]; g1[4 * q + j] = a[j] * rn; g2[4 * q + j] = b[j] * rn; } }
        float o1[8], o2[8];
#pragma unroll
        for (int j = 0; j < 8; ++j) { const float x1 = __builtin_bit_cast(float, (unsigned)(unsigned short)qr[d1][j] << 16) * g1[j], x2 = __builtin_bit_cast(float, (unsigned)(unsigned short)qr[d2][j] << 16) * g2[j];
          o1[j] = x1 * cs[j] - x2 * sn[j]; o2[j] = x2 * cs[j] + x1 * sn[j]; }
        { u32x4 w = {cvtpk(o1[0], o1[1]), cvtpk(o1[2], o1[3]), cvtpk(o1[4], o1[5]), cvtpk(o1[6], o1[7])}; qr[d1] = *reinterpret_cast<bf16x8*>(&w); }
        { u32x4 w = {cvtpk(o2[0], o2[1]), cvtpk(o2[2], o2[3]), cvtpk(o2[4], o2[5]), cvtpk(o2[6], o2[7])}; qr[d2] = *reinterpret_cast<bf16x8*>(&w); } } }
  }
  const int sr = tid / TPR, sc = (tid % TPR) * 8;
  int vst[NP], kst[NP];
#pragma unroll
  for (int p = 0; p < NP; ++p) { vst[p] = v_st<D>(sr + p * RPP, sc); kst[p] = kswz<D>(sr + p * RPP, sc * 2); }
  const int vb0 = (int)(uintptr_t)V_lds + v_rd_base(lane);
  const int dqb = 4 * hi - (qpos0 + wid * 32 + r32);
  bf16x8 sv0[NP], sk0[NP], sv1[NP], sk1[NP];
#define KROW(j) ((j) < nwin ? wstart + 64 * (j) : cstart + 64 * ((j) - nwin))
#define SLOAD(SV, SK, j) do { const long rb_ = (long)KROW(j) + sr; _Pragma("unroll") for (int p = 0; p < NP; ++p) { \
    SV[p] = *reinterpret_cast<const bf16x8*>(Vb + (rb_ + p * RPP) * LD + sc); SK[p] = *reinterpret_cast<const bf16x8*>(Kb + (rb_ + p * RPP) * LD + sc); } } while (0)
#define SWRITE(b, SV, SK) do { _Pragma("unroll") for (int p = 0; p < NP; ++p) { *reinterpret_cast<bf16x8*>(V_lds + (b) * SHM_V + vst[p]) = SV[p]; \
    *reinterpret_cast<bf16x8*>(K_lds + (b) * SHM_K + kst[p]) = SK[p]; } } while (0)
#define SWAIT() do { if constexpr (NP == 2) asm volatile("s_waitcnt vmcnt(4)" ::: "memory"); else asm volatile("s_waitcnt vmcnt(2)" ::: "memory"); } while (0)
#define RESC(a) do { if (__any((a) < 1.f)) { if (hi == 0) al_l[r32] = (a); asm volatile("s_waitcnt lgkmcnt(0)" ::: "memory"); \
    _Pragma("unroll") for (int d = 0; d < NDO; ++d) _Pragma("unroll") for (int r = 0; r < 16; ++r) o[d][r] *= al_l[crow(r, hi)]; } } while (0)
#define MASKT(PA, PB, j) do { if constexpr (MASK) { if ((j) < nwin) { const int k0_ = wstart + 64 * (j); if (k0_ - tqw > 65 || tqw - k0_ > 97) wmask(PA, PB, k0_ + dqb); } } } while (0)
  f32x16 pA0, pA1, pB0, pB1; float mnA, mnB, alA, alB; bf16x8 pa0, pa1, pa2, pa3;
  const int tqw = qpos0 + __builtin_amdgcn_readfirstlane(wid) * 32;
#define ACT(j) (!MASK || (j) >= nwin || (wstart + 64 * (j) <= tqw + 159 && wstart + 64 * (j) + 63 >= tqw - 128))
  bool actA, actB;
  SLOAD(sv0, sk0, 0); asm volatile("s_waitcnt vmcnt(0)" ::: "memory"); SWRITE(0, sv0, sk0); __syncthreads();
  actA = ACT(0);
  if (actA) { qkt<D>(pA0, pA1, K_lds, qr, r32, hi); MASKT(pA0, pA1, 0); partialSM<D>(pA0, pA1, m_reg, mnA, alA); } else alA = 1.f;
  SLOAD(sv1, sk1, 1); if (2 < NT) SLOAD(sv0, sk0, 2);
  SWAIT(); SWRITE(1, sv1, sk1); __syncthreads();
  for (int j = 1; j + 1 < NT; j += 2) {
    actB = ACT(j);
    SBAR(); if (actB) qkt<D>(pB0, pB1, K_lds + SHM_K, qr, r32, hi);
    if (actA) finishSM(pA0, pA1, alA, l_reg, pa0, pa1, pa2, pa3); SBAR();
    SLOAD(sv1, sk1, j + 2); SBAR();
    if (actA) pv_all<D>(o, vb0, pa0, pa1, pa2, pa3);
    if (actB) { MASKT(pB0, pB1, j); partialSM<D>(pB0, pB1, m_reg, mnB, alB); } else alB = 1.f;
    __syncthreads(); SWAIT(); SWRITE(0, sv0, sk0);
    RESC(alB); __syncthreads();
    actA = ACT(j + 1);
    SBAR(); if (actA) qkt<D>(pA0, pA1, K_lds, qr, r32, hi);
    if (actB) finishSM(pB0, pB1, alB, l_reg, pa0, pa1, pa2, pa3); SBAR();
    if (j + 3 < NT) SLOAD(sv0, sk0, j + 3); SBAR();
    if (actB) pv_all<D>(o, vb0 + SHM_V, pa0, pa1, pa2, pa3);
    if (actA) { MASKT(pA0, pA1, j + 1); partialSM<D>(pA0, pA1, m_reg, mnA, alA); } else alA = 1.f;
    __syncthreads(); SWAIT(); SWRITE(1, sv1, sk1);
    RESC(alA); __syncthreads();
  }
  actB = ACT(NT - 1);
  SBAR(); if (actB) qkt<D>(pB0, pB1, K_lds + SHM_K, qr, r32, hi);
  if (actA) finishSM(pA0, pA1, alA, l_reg, pa0, pa1, pa2, pa3); SBAR();
  if (actA) pv_all<D>(o, vb0, pa0, pa1, pa2, pa3);
  if (actB) { MASKT(pB0, pB1, NT - 1); partialSM<D>(pB0, pB1, m_reg, mnB, alB); } else alB = 1.f;
  __syncthreads(); RESC(alB);
  if (actB) { finishSM(pB0, pB1, alB, l_reg, pa0, pa1, pa2, pa3); SBAR();
    pv_all<D>(o, vb0 + SHM_V, pa0, pa1, pa2, pa3); }
#undef ACT
  if (hi == 0) li_l[r32] = l_reg; asm volatile("s_waitcnt lgkmcnt(0)" ::: "memory");
  float rli[16];
#pragma unroll
  for (int r = 0; r < 16; ++r) rli[r] = __builtin_amdgcn_rcpf(li_l[crow(r, hi)]);
  bf16* Ow = Ob + (long)(wid * 32) * LDO;
#pragma unroll
  for (int r = 0; r < 16; ++r) { const int orow = crow(r, hi);
#pragma unroll
    for (int d0 = 0; d0 < NDO; ++d0) { const float v = o[d0][r] * rli[r]; Ow[(long)orow * LDO + d0 * 32 + r32] = (bf16)(cvtpk(v, v) & 0xffffu); } }
#undef KROW
#undef SLOAD
#undef SWRITE
#undef SWAIT
#undef RESC
#undef MASKT
}
}

#ifndef MK_N_LAUNCHES
#define MK_N_LAUNCHES 1
#endif
#ifndef DBG_STAGE
#define DBG_STAGE 0
#endif
#ifndef DUP_MASK
#define DUP_MASK 0
#endif
#define NREP(p) ((((DUP_MASK) >> (p)) & 1) ? 2 : 1)
#ifndef DBL_BAR
#define DBL_BAR 0
#endif
#ifndef DBG_PROBE
#define DBG_PROBE 0
#endif
#define PROBE_ON (((DBG_PROBE) >> 8) & 1)
#define PROBE_PH ((DBG_PROBE) & 0xff)
#define PROBE_STAMP(k) do { if (PROBE_ON && blockIdx.x == 0 && threadIdx.x == 0) { volatile LAS unsigned* pm_ = (volatile LAS unsigned*)(lds + MISC_OFF) + 16; const unsigned now_ = (unsigned)__builtin_amdgcn_s_memrealtime(); \
        if ((k) == PROBE_PH) pm_[1] = now_ - pm_[0]; if (PROBE_PH != 255) pm_[0] = now_; else if ((k) == NPH - 1) pm_[1] = now_ - pm_[0]; } } while (0)
constexpr int NPH = 18;

constexpr size_t MiB = 1u << 20;
constexpr size_t WS_CTL = 0, CTL_ZERO_BYTES = 49152;
constexpr size_t WS_MODS = 1 * MiB;
constexpr size_t WS_ROPE = WS_MODS + 512 * 1024;
constexpr size_t WS_WQA = 2 * MiB, WS_WOA = 5 * MiB, WS_WQB = 7 * MiB, WS_WOB = 10 * MiB;
constexpr size_t WS_W1 = 16 * MiB;
constexpr size_t WS_W2 = 272 * MiB;
constexpr size_t WS_H8 = 336 * MiB;
constexpr float WSCALE = 32.0f;
constexpr size_t WS_H = 400 * MiB;
constexpr size_t WS_QKV = 436 * MiB;
constexpr size_t WS_AO = 490 * MiB;
constexpr size_t WS_AP = 526 * MiB;
constexpr size_t WS_XB = 562 * MiB;
constexpr size_t WS_RT = 634 * MiB;
constexpr size_t RT_STRIDE = (size_t)T * 4 * 4;
constexpr size_t WS_LIST = 635 * MiB;
constexpr size_t WS_ACT = 638 * MiB;
constexpr size_t WS_Y = 798 * MiB;
constexpr size_t WS_END = 958 * MiB;
static_assert(WS_ROPE + 6400 * 4 <= WS_WQA && WS_WOB + 2 * MiB <= WS_W1 && WS_LIST + (size_t)NE * CAP * 4 <= WS_ACT && WS_RT + 3 * RT_STRIDE <= WS_LIST, "d_ws map");
static_assert((8192 + 64 * 64) * 4 <= (int)CTL_ZERO_BYTES && (4096 + 3456) * 4 <= 8192 * 4, "control words inside the memset region");
constexpr int CW_BAR = 4096;
constexpr int CW_CNT = 8192;

constexpr int RING_BYTES = 131072;
constexpr int MISC_OFF = RING_BYTES;
constexpr int TAB_OFF = RING_BYTES + 256;
constexpr int RSCR_OFF = RING_BYTES + 1024;
constexpr int LDS_BYTES = 147456;

#define LDS_WAIT() asm volatile("s_waitcnt lgkmcnt(0)" ::: "memory")
#define VM_WAIT() asm volatile("s_waitcnt vmcnt(0)" ::: "memory")
__device__ __forceinline__ unsigned f2bf(float f) { unsigned u = __builtin_bit_cast(unsigned, f); return (u + 0x7fffu + ((u >> 16) & 1u)) >> 16; }
__device__ __forceinline__ unsigned pk2(float lo, float hi) { return f2bf(lo) | (f2bf(hi) << 16); }
__device__ __forceinline__ float bflo(unsigned w) { return __builtin_bit_cast(float, w << 16); }
__device__ __forceinline__ float bfhi(unsigned w) { return __builtin_bit_cast(float, w & 0xffff0000u); }

#define XB_TMO      128
#define XB_XCNT(j)  (256  + 64 * (j))
#define XB_XSUB(j)  (1280 + 64 * (j))
#define XB_XGEN(j)  (2304 + 64 * (j))
#define XB_TOP      3328
#define XB_TOPGEN   3392
#define XCD_BAR_WORDS 3456
#define XB_SPIN_CAP (1u << 18)

__device__ __forceinline__ unsigned xb_ld(unsigned* p)              { return __hip_atomic_load(p, __ATOMIC_RELAXED, __HIP_MEMORY_SCOPE_AGENT); }
__device__ __forceinline__ unsigned xb_add(unsigned* p, unsigned v) { return __hip_atomic_fetch_add(p, v, __ATOMIC_RELAXED, __HIP_MEMORY_SCOPE_AGENT); }
__device__ __forceinline__ unsigned xb_xcc_id() { return (unsigned)__builtin_amdgcn_s_getreg((3 << 11) | 20) & 0xFu; }
#define XB_SPIN(cond, bar) do { unsigned _sp = 0; while (cond) { __builtin_amdgcn_s_sleep(1); \
    if ((++_sp & 255u) == 0u) { if (xb_ld(&(bar)[XB_TMO])) break; if (_sp > XB_SPIN_CAP) { atomicAdd(&(bar)[XB_TMO], 1u); break; } } } } while (0)

struct XcdBarrier {
    unsigned* bar; unsigned x;
    volatile LAS unsigned* st;
};

__device__ __forceinline__ XcdBarrier xcd_barrier_post(unsigned* bar, volatile LAS unsigned* st) {
    XcdBarrier b; b.bar = bar; b.x = xb_xcc_id(); b.st = st;
    if (threadIdx.x == 0) (void)xb_add(&bar[XB_XCNT(b.x)], 1u);
    return b;
}
__device__ __forceinline__ void xcd_barrier_complete(unsigned* bar, unsigned x, unsigned& nloc, unsigned& nx) {
    const unsigned G = gridDim.x * gridDim.y * gridDim.z;
    unsigned sum, cnt, mine, sp = 0u;
    for (;;) {
        sum = 0u; cnt = 0u; mine = 0u;
#pragma unroll
        for (unsigned j = 0; j < 16; ++j) { const unsigned c = xb_ld(&bar[XB_XCNT(j)]); sum += c; cnt += (c > 0u) ? 1u : 0u; mine = (j == x) ? c : mine; }
        if (sum == G) break;
        __builtin_amdgcn_s_sleep(1);
        if ((++sp & 255u) == 0u) { if (xb_ld(&bar[XB_TMO])) break; if (sp > XB_SPIN_CAP) { atomicAdd(&bar[XB_TMO], 1u); break; } }
    }
    nloc = mine > 0u ? mine : 1u; nx = cnt > 0u ? cnt : 1u;
}

__device__ __forceinline__ void xcd_barrier(const XcdBarrier& b) {
    asm volatile("s_waitcnt vmcnt(0)" ::: "memory");
    __syncthreads();
    if (threadIdx.x == 0) {
        unsigned* bar = b.bar;
        __builtin_amdgcn_s_waitcnt(0);
        unsigned nloc = b.st[0], nx = b.st[1];
        if (nloc == 0u) { xcd_barrier_complete(bar, b.x, nloc, nx); b.st[0] = nloc; b.st[1] = nx; }
        const unsigned old = xb_add(&bar[XB_XSUB(b.x)], 1u);
        const unsigned gen = old / nloc;
        if (old + 1u == (gen + 1u) * nloc) {
            __builtin_amdgcn_fence(__ATOMIC_RELEASE, "agent");
            asm volatile("s_waitcnt vmcnt(0)" ::: "memory");
            const unsigned og = xb_add(&bar[XB_TOP], 1u);
            const unsigned tg = og / nx;
            if (og + 1u == (tg + 1u) * nx) xb_add(&bar[XB_TOPGEN], 1u);
            else XB_SPIN(xb_ld(&bar[XB_TOPGEN]) == tg, bar);
            __builtin_amdgcn_fence(__ATOMIC_ACQUIRE, "agent");
            xb_add(&bar[XB_XGEN(b.x)], 1u);
            asm volatile("s_waitcnt vmcnt(0)" ::: "memory");
        } else {
            XB_SPIN(xb_ld(&bar[XB_XGEN(b.x)]) == gen, bar);
            __builtin_amdgcn_fence(__ATOMIC_ACQUIRE, "agent");
            asm volatile("s_waitcnt vmcnt(0)" ::: "memory");
        }
    }
    __syncthreads();
}

struct Args { const float* in[NIN]; float* out; unsigned char* ws; int ph_lo, ph_hi; };

__device__ __forceinline__ float wave_sum(float v) {
#pragma unroll
    for (int o = 1; o < 64; o <<= 1) v += __shfl_xor(v, o);
    return v;
}
struct Row { f32x4 v[4]; };
__device__ __forceinline__ Row ld_row_f32(const float* p, int lane) { Row r; const f32x4* q = (const f32x4*)p + lane;
#pragma unroll
    for (int j = 0; j < 4; ++j) r.v[j] = q[64 * j];
    return r; }
__device__ __forceinline__ Row ld_row_f32_nt(const float* p, int lane) { Row r; const f32x4* q = (const f32x4*)p + lane;
#pragma unroll
    for (int j = 0; j < 4; ++j) r.v[j] = __builtin_nontemporal_load(q + 64 * j);
    return r; }
__device__ __forceinline__ void st_row_f32_nt(float* p, int lane, const Row& r) { f32x4* q = (f32x4*)p + lane;
#pragma unroll
    for (int j = 0; j < 4; ++j) __builtin_nontemporal_store(r.v[j], q + 64 * j); }
__device__ __forceinline__ Row ld_row_bf16(const bf16* p, int lane) { Row r; const u32x2* q = (const u32x2*)p + lane;
#pragma unroll
    for (int j = 0; j < 4; ++j) { const u32x2 w = q[64 * j]; r.v[j] = (f32x4){bflo(w.x), bfhi(w.x), bflo(w.y), bfhi(w.y)}; }
    return r; }
__device__ __forceinline__ Row ld_row_fp8(const unsigned char* p, int lane) { Row r; const unsigned* q = (const unsigned*)p + lane;
#pragma unroll
    for (int j = 0; j < 4; ++j) { const int w = (int)q[64 * j]; const auto lo = __builtin_amdgcn_cvt_pk_f32_fp8(w, false), hi = __builtin_amdgcn_cvt_pk_f32_fp8(w, true); r.v[j] = (f32x4){lo[0], lo[1], hi[0], hi[1]}; }
    return r; }
struct RawBf { u32x2 v[4]; };
struct RawF8 { unsigned v[4]; };
__device__ __forceinline__ RawBf ld_raw_bf16(const bf16* p, int lane) { RawBf r; const u32x2* q = (const u32x2*)p + lane;
#pragma unroll
    for (int j = 0; j < 4; ++j) r.v[j] = q[64 * j];
    return r; }
__device__ __forceinline__ RawF8 ld_raw_fp8(const unsigned char* p, int lane) { RawF8 r; const unsigned* q = (const unsigned*)p + lane;
#pragma unroll
    for (int j = 0; j < 4; ++j) r.v[j] = q[64 * j];
    return r; }
__device__ __forceinline__ Row cvt_raw(const RawBf& w) { Row r;
#pragma unroll
    for (int j = 0; j < 4; ++j) r.v[j] = (f32x4){bflo(w.v[j].x), bfhi(w.v[j].x), bflo(w.v[j].y), bfhi(w.v[j].y)};
    return r; }
__device__ __forceinline__ Row cvt_raw(const RawF8& w) { Row r;
#pragma unroll
    for (int j = 0; j < 4; ++j) { const auto lo = __builtin_amdgcn_cvt_pk_f32_fp8((int)w.v[j], false), hi = __builtin_amdgcn_cvt_pk_f32_fp8((int)w.v[j], true); r.v[j] = (f32x4){lo[0], lo[1], hi[0], hi[1]}; }
    return r; }
__device__ __forceinline__ void st_row_f32(float* p, int lane, const Row& r) { f32x4* q = (f32x4*)p + lane;
#pragma unroll
    for (int j = 0; j < 4; ++j) q[64 * j] = r.v[j]; }
__device__ __forceinline__ void st_row_bf16(bf16* p, int lane, const Row& r) { u32x2* q = (u32x2*)p + lane;
#pragma unroll
    for (int j = 0; j < 4; ++j) { u32x2 w; w.x = pk2(r.v[j].x, r.v[j].y); w.y = pk2(r.v[j].z, r.v[j].w); q[64 * j] = w; } }
__device__ __forceinline__ float row_rs(const Row& r) {
    float s = 0.f;
#pragma unroll
    for (int j = 0; j < 4; ++j) s += (r.v[j].x * r.v[j].x + r.v[j].y * r.v[j].y) + (r.v[j].z * r.v[j].z + r.v[j].w * r.v[j].w);
    return 1.0f / sqrtf(wave_sum(s) * (1.0f / DM) + EPS);
}
__device__ __forceinline__ Row norm_mod(const Row& x, float rs, const float* g, const float* sh, const float* sc, int lane) {
    const Row G = ld_row_f32(g, lane), SH = ld_row_f32(sh, lane), SC = ld_row_f32(sc, lane); Row h;
#pragma unroll
    for (int j = 0; j < 4; ++j) h.v[j] = (x.v[j] * rs * G.v[j]) * (SC.v[j] + 1.0f) + SH.v[j];
    return h;
}
__device__ __forceinline__ const float* src_row(const Args& a, int row) { const int b = row / RPB, t = row % RPB;
    return t < SEQ ? a.in[0] + ((size_t)b * SEQ + t) * DM : a.in[2] + ((size_t)b * CTXL + (t - SEQ)) * DM; }

template <int MODE>
__device__ __forceinline__ void transpose_item(const float* W, int K, int N, bf16* WT, LAS float* scr, int item, int lane) {
    const int nblk = N / 32, kb = item / nblk, nb = item % nblk, k0 = 64 * kb, n0 = 32 * nb;
#pragma unroll 8
    for (int i = 0; i < 32; ++i) { const int kk = 2 * i + (lane >> 5); scr[kk * 33 + (lane & 31)] = __builtin_nontemporal_load(W + (size_t)(k0 + kk) * N + n0 + (lane & 31)); }
    LDS_WAIT(); asm volatile("" ::: "memory");
    const int c = lane & 7;
#pragma unroll
    for (int j = 0; j < 4; ++j) { const int n = (lane >> 3) + 8 * j; const LAS float* s = scr + (8 * c) * 33 + n;
        u32x4 o; o.x = pk2(s[0 * 33], s[1 * 33]); o.y = pk2(s[2 * 33], s[3 * 33]); o.z = pk2(s[4 * 33], s[5 * 33]); o.w = pk2(s[6 * 33], s[7 * 33]);
        int nn = n0 + n;
        if (MODE == 2 && nn < 1152) { const int d = nn & 63, reg = d >> 4, i = d & 15; nn = (nn & ~63) + (((reg >> 1) * 4 + (i >> 2)) * 8) + ((reg & 1) * 4 + (i & 3)); }
        *(u32x4*)(WT + (size_t)nn * K + k0 + 8 * c) = o; }
    LDS_WAIT(); asm volatile("" ::: "memory");
}
__device__ __forceinline__ unsigned pack4_fp8(float a, float b, float c, float d) { int w = 0; w = __builtin_amdgcn_cvt_pk_fp8_f32(a, b, w, false); w = __builtin_amdgcn_cvt_pk_fp8_f32(c, d, w, true); return (unsigned)w; }
template <int MODE, bool NTST = true>
__device__ __forceinline__ void transpose_item_f8(const float* W, int K, int N, unsigned char* WT, LAS float* scr, int item, int lane) {
    const int nblk = N / 32, kb = item / nblk, nb = item % nblk, k0 = 128 * kb, n0 = 32 * nb;
    float tv[64];
#pragma unroll
    for (int i = 0; i < 64; ++i) { const int kk = 2 * i + (lane >> 5); tv[i] = __builtin_nontemporal_load(W + (size_t)(k0 + kk) * N + n0 + (lane & 31)); }
    const int c = lane & 3;
    u32x4 o[2][2];
#pragma unroll
    for (int h = 0; h < 2; ++h) {
#pragma unroll
        for (int i = 0; i < 32; ++i) { const int kk = 2 * i + (lane >> 5); scr[kk * 33 + (lane & 31)] = tv[32 * h + i] * WSCALE; }
        LDS_WAIT(); asm volatile("" ::: "memory");
#pragma unroll
        for (int j = 0; j < 2; ++j) { const int n = (lane >> 2) + 16 * j; const LAS float* s = scr + (16 * c) * 33 + n;
            o[h][j].x = pack4_fp8(s[0 * 33], s[1 * 33], s[2 * 33], s[3 * 33]); o[h][j].y = pack4_fp8(s[4 * 33], s[5 * 33], s[6 * 33], s[7 * 33]);
            o[h][j].z = pack4_fp8(s[8 * 33], s[9 * 33], s[10 * 33], s[11 * 33]); o[h][j].w = pack4_fp8(s[12 * 33], s[13 * 33], s[14 * 33], s[15 * 33]); }
        LDS_WAIT(); asm volatile("" ::: "memory");
    }
#pragma unroll
    for (int j = 0; j < 2; ++j) { int nn = n0 + (lane >> 2) + 16 * j;
        if (MODE == 1) nn = (nn < 1024) ? ((nn >> 7) * 256 + (nn & 127)) : ((((nn - 1024) >> 7) * 256) + 128 + (nn & 127));
        unsigned char* rowp = WT + (size_t)nn * K + k0 + 16 * c;
        if constexpr (NTST) { __builtin_nontemporal_store(o[0][j], (u32x4*)rowp); __builtin_nontemporal_store(o[1][j], (u32x4*)(rowp + 64)); }
        else { *(u32x4*)rowp = o[0][j]; *(u32x4*)(rowp + 64) = o[1][j]; } }
}
__device__ __forceinline__ void mods_item(const float* w_ada, const float* b_ada, float* mods, const LAS float* S, int it, int lane) {
    const int l = it / 384, cc = it % 384, kq = lane >> 4, col = cc * 16 + (lane & 15);
    const float* W = w_ada + (size_t)l * DM * 6144 + col;
    float acc[9];
#pragma unroll
    for (int r = 0; r < 9; ++r) acc[r] = 0.f;
#pragma unroll 8
    for (int kk = 0; kk < 256; ++kk) { const int k = kk * 4 + kq; const float w = __builtin_nontemporal_load(W + (size_t)k * 6144);
#pragma unroll
        for (int r = 0; r < 9; ++r) acc[r] += S[r * 1024 + k] * w; }
#pragma unroll
    for (int r = 0; r < 9; ++r) { acc[r] += __shfl_xor(acc[r], 16); acc[r] += __shfl_xor(acc[r], 32); }
    if (lane < 16) { const float bb = b_ada[l * 6144 + col];
#pragma unroll
        for (int r = 0; r < 9; ++r) mods[((size_t)l * 9 + r) * 6144 + col] = acc[r] + bb; }
}
constexpr int I_MOD = 2 * 384, I_QA = 16 * (NQA / 32), I_O = 16 * 32, I_QB = 16 * (NQB / 32), I_W1 = 64 * 512, I_W2 = 64 * 256;
constexpr int N_ITEMS0 = I_MOD + I_QA + I_O + I_QB + I_O;
#ifndef W1_LATE
#define W1_LATE 0
#endif
#ifndef MODS_SPLIT
#define MODS_SPLIT 1
#endif
#ifndef TOKB_RPI
#define TOKB_RPI 3
#endif
#ifndef EARLY_A
#define EARLY_A 3
#endif
#ifndef EARLY_B
#define EARLY_B 6
#endif
#ifndef W1_FIRST
#define W1_FIRST 0
#endif
#ifndef MODS_WORTH
#define MODS_WORTH 10
#endif

__device__ __forceinline__ void phase_pro_a(const Args& a, unsigned char* ws, LAS unsigned char* lds, int tid, int lane, int wave, int vcu, int G) {
    LAS float* S = (LAS float*)(lds + 69632);
    for (int i = tid; i < 9 * 1024; i += 512) { const float v = i < 8192 ? a.in[1][i] : a.in[3][i - 8192]; S[i] = v / (1.0f + expf(-v)); }
    __syncthreads();
    LAS float* scr = (LAS float*)(lds + wave * 8448);
    const int gw = vcu * 8 + wave, NGW = G * 8;
    if (MODS_SPLIT) {
        LAS float* part = (LAS float*)(lds + 106496);
        for (int it = vcu; it < I_MOD; it += G) {
            const int l = it / 384, cc = it % 384, kq = lane >> 4, col = cc * 16 + (lane & 15);
            const float* W = a.in[4] + (size_t)l * DM * 6144 + col;
            float w[32];
#pragma unroll
            for (int kk = 0; kk < 32; ++kk) w[kk] = __builtin_nontemporal_load(W + (size_t)(wave * 128 + kk * 4 + kq) * 6144);
            float acc[9];
#pragma unroll
            for (int r = 0; r < 9; ++r) acc[r] = 0.f;
#pragma unroll
            for (int kk = 0; kk < 32; ++kk) { const int k = wave * 128 + kk * 4 + kq;
#pragma unroll
                for (int r = 0; r < 9; ++r) acc[r] += S[r * 1024 + k] * w[kk]; }
#pragma unroll
            for (int r = 0; r < 9; ++r) { acc[r] += __shfl_xor(acc[r], 16); acc[r] += __shfl_xor(acc[r], 32); }
            if (lane < 16) {
#pragma unroll
                for (int r = 0; r < 9; ++r) part[(wave * 9 + r) * 16 + lane] = acc[r]; }
            __syncthreads();
            if (tid < 144) { const int r = tid >> 4, c = tid & 15; float v = a.in[5][l * 6144 + cc * 16 + c];
#pragma unroll
                for (int w8 = 0; w8 < 8; ++w8) v += part[(w8 * 9 + r) * 16 + c];
                ((float*)(ws + WS_MODS))[((size_t)l * 9 + r) * 6144 + cc * 16 + c] = v; }
            __syncthreads();
        }
        for (int it = gw; it < N_ITEMS0 - I_MOD; it += NGW) {
            int r = it;
            if (r < I_QA) { transpose_item<2>(a.in[7], DM, NQA, (bf16*)(ws + WS_WQA), scr, r, lane); continue; } r -= I_QA;
            if (r < I_O) { transpose_item<0>(a.in[8], DM, DM, (bf16*)(ws + WS_WOA), scr, r, lane); continue; } r -= I_O;
            if (r < I_QB) { transpose_item<0>(a.in[10], DM, NQB, (bf16*)(ws + WS_WQB), scr, r, lane); continue; } r -= I_QB;
            transpose_item<0>(a.in[13], DM, DM, (bf16*)(ws + WS_WOB), scr, r, lane);
        }
    } else
    for (int it = gw; it < N_ITEMS0; it += NGW) {
        int r = it;
        if (r < I_MOD) { mods_item(a.in[4], a.in[5], (float*)(ws + WS_MODS), S, r, lane); continue; } r -= I_MOD;
        if (r < I_QA) { transpose_item<2>(a.in[7], DM, NQA, (bf16*)(ws + WS_WQA), scr, r, lane); continue; } r -= I_QA;
        if (r < I_O) { transpose_item<0>(a.in[8], DM, DM, (bf16*)(ws + WS_WOA), scr, r, lane); continue; } r -= I_O;
        if (r < I_QB) { transpose_item<0>(a.in[10], DM, NQB, (bf16*)(ws + WS_WQB), scr, r, lane); continue; } r -= I_QB;
        transpose_item<0>(a.in[13], DM, DM, (bf16*)(ws + WS_WOB), scr, r, lane);
    }
    if (!W1_LATE) { constexpr int NC = I_W1 + I_W2; const int nfree = NGW > I_MOD ? NGW - I_MOD : 0, A = nfree ? NC - (MODS_WORTH * nfree < NC ? MODS_WORTH * nfree : NC) : NC;
#define MOE_ITEM(r_) do { const int r__ = (r_); if (r__ < I_W1) { const int m = r__ >> 9; transpose_item_f8<1>(a.in[16] + (size_t)m * DM * 2048, DM, 2048, ws + WS_W1 + (size_t)m * 2048 * DM, scr, r__ & 511, lane); } \
        else { const int q__ = r__ - I_W1, m = q__ >> 8; transpose_item_f8<0>(a.in[18] + (size_t)m * DM * DM, DM, DM, ws + WS_W2 + (size_t)m * DM * DM, scr, q__ & 255, lane); } } while (0)
      for (int it = gw; it < A; it += NGW) MOE_ITEM(it);
      if (gw >= I_MOD) for (int it = A + gw - I_MOD; it < NC; it += nfree) MOE_ITEM(it);
#undef MOE_ITEM
    }
    if (vcu == 0) {
        float* rp = (float*)(ws + WS_ROPE);
        for (int i = tid; i < 1024; i += 512) { const int pos = i >> 4, f = i & 15; const float inv = exp2f(-(float)f * (13.287712379549449f / 16.0f)); const float ang = (float)pos * inv;
            rp[i] = cosf(ang); rp[1024 + i] = sinf(ang); }
        for (int i = tid; i < 2048; i += 512) { const int pos = i >> 5, f = i & 31; const float inv = exp2f(-(float)f * (13.287712379549449f / 32.0f)); const float ang = (float)pos * inv;
            rp[2048 + i] = cosf(ang); rp[4096 + i] = sinf(ang); }
        if (tid < 128) rp[6144 + tid] = a.in[11][tid];
    }
}
__device__ __forceinline__ void phase_pro_b(const Args& a, unsigned char* ws, int lane, int gw, int NGW) {
    const float* mods = (const float*)(ws + WS_MODS); bf16* H = (bf16*)(ws + WS_H);
    if (gw >= T) return;
    Row nx = ld_row_f32(src_row(a, gw), lane);
    for (int row = gw; row < T; row += NGW) {
        const Row x = nx; const int nrow = row + NGW < T ? row + NGW : row; nx = ld_row_f32(src_row(a, nrow), lane);
        const int b = row / RPB, t = row % RPB; const float* mod = mods + (size_t)(t < SEQ ? b : 8) * 6144;
        const Row h = norm_mod(x, row_rs(x), a.in[6], mod, mod + 1024, lane);
        st_row_bf16(H + (size_t)row * DM, lane, h);
    }
}
__device__ __forceinline__ void phase_qkfix_b(const Args& a, unsigned char* ws, int gtid, int NGT) {
    bf16* QKV = (bf16*)(ws + WS_QKV); const float* rc = (const float*)(ws + WS_ROPE) + 2048; const float* rs = rc + 2048;
    for (int f = gtid; f < T * 80; f += NGT) {
        const int sub = f & 7, hd = (f >> 3) % 10, row = f / 80, t = row % RPB; const bool lat = t < SEQ;
        if (!lat && hd < 8) continue;
        const int half = sub >> 2, c = (sub & 3) + half * 8, pos = half ? (t & 63) : (t >> 6), f0 = (sub & 3) * 8;
        bf16* p1 = QKV + (size_t)row * NQB + hd * 128 + c * 8; bf16* p2 = p1 + 32;
        const u32x4 A = *(const u32x4*)p1, Bv = *(const u32x4*)p2; u32x4 OA, OB;
        float ss = 0.f;
#pragma unroll
        for (int i = 0; i < 4; ++i) { const float x10 = bflo(A[i]), x11 = bfhi(A[i]), x20 = bflo(Bv[i]), x21 = bfhi(Bv[i]); ss += (x10 * x10 + x11 * x11) + (x20 * x20 + x21 * x21); }
        ss += __shfl_xor(ss, 1); ss += __shfl_xor(ss, 2); ss += __shfl_xor(ss, 4);
        const float rn = 1.0f / sqrtf(ss * (1.0f / 128.0f) + EPS);
        const float* gn = (hd < 8 ? a.in[11] : a.in[12]);
#pragma unroll
        for (int i = 0; i < 4; ++i) {
            const int e1 = c * 8 + 2 * i, e2 = e1 + 32;
            const float y10 = bflo(A[i]) * rn * gn[e1], y11 = bfhi(A[i]) * rn * gn[e1 + 1], y20 = bflo(Bv[i]) * rn * gn[e2], y21 = bfhi(Bv[i]) * rn * gn[e2 + 1];
            if (lat) {
                const float cs0 = rc[pos * 32 + f0 + 2 * i], sn0 = rs[pos * 32 + f0 + 2 * i], cs1 = rc[pos * 32 + f0 + 2 * i + 1], sn1 = rs[pos * 32 + f0 + 2 * i + 1];
                OA[i] = pk2(y10 * cs0 - y20 * sn0, y11 * cs1 - y21 * sn1); OB[i] = pk2(y20 * cs0 + y10 * sn0, y21 * cs1 + y11 * sn1);
            } else { OA[i] = pk2(y10, y11); OB[i] = pk2(y20, y21); } }
        *(u32x4*)p1 = OA; *(u32x4*)p2 = OB;
    }
}
__device__ __forceinline__ void phase_attn_a(const Args& a, unsigned char* ws, char* lds, int vcu, int G) {
    const bf16* QKV = (const bf16*)(ws + WS_QKV); bf16* AO = (bf16*)(ws + WS_AO);
    constexpr int NU = NB * 16 * 8 + NB * 16;
    for (int u = vcu; u < NU; u += G) {
        __syncthreads();
        if (u < NB * 128) {
            const int b = u >> 7, h = (u >> 3) & 15, qb = u & 7, g = h >> 3, q0 = qb * 256;
            const int ws0 = q0 >= 128 ? q0 - 128 : 0, we = q0 + 384 < SEQ ? q0 + 384 : SEQ, nwin = (we - ws0) >> 6;
            const bf16* base = QKV + (size_t)b * RPB * NQA;
            att::attn_unit<64, true, NQA>(base + (size_t)q0 * NQA + h * 64, base + 1024 + g * 64, base + 1152 + g * 64, AO + ((size_t)b * RPB + q0) * DM + h * 64,
                                          nwin, ws0, SEQ, nwin + 4, q0, a.in[9][h] * 8.0f, 1.0f, lds);
        } else {
            const int v = u - NB * 128, b = v >> 4, h = v & 15, g = h >> 3;
            const bf16* base = QKV + (size_t)b * RPB * NQA;
            att::attn_unit<64, false, NQA>(base + (size_t)SEQ * NQA + h * 64, base + 1024 + g * 64, base + 1152 + g * 64, AO + ((size_t)b * RPB + SEQ) * DM + h * 64,
                                           0, 0, SEQ, 4, 0, a.in[9][h] * 8.0f, 1.0f, lds);
        }
    }
}
__device__ __forceinline__ void phase_attn_b(const Args& a, unsigned char* ws, char* lds, int vcu, int G) {
    const bf16* QKV = (const bf16*)(ws + WS_QKV); bf16* AO = (bf16*)(ws + WS_AO);
    constexpr int NU = NB * 8 * 8;
    for (int u = vcu; u < NU; u += G) {
        __syncthreads();
        const int b = u >> 6, h = (u >> 3) & 7, qb = u & 7, g = h >> 2, q0 = qb * 256;
        const bf16* base = QKV + (size_t)b * RPB * NQB;
        att::attn_unit<128, false, NQB>(base + (size_t)q0 * NQB + h * 128, base + 1024 + g * 128, base + 1280 + g * 128, AO + ((size_t)b * RPB + q0) * DM + h * 128,
                                        36, 0, 0, 36, q0, -1e30f, 0.0f, lds);
    }
}
__device__ __forceinline__ void phase_tok_b(const Args& a, unsigned char* ws, LAS unsigned char* lds, int l, int tid, int lane, int wave, int gw, int NGW) {
    constexpr int SLOTS = 12;
    constexpr int RPI = TOKB_RPI, NTK = 8 * RPI;
    constexpr int ROWB = 2048 + 16, TILE_LO = NTK * ROWB, RED_OFF = 2 * NTK * ROWB;
    static_assert(SLOTS % RPI == 0 && NTK <= 32 && RED_OFF + 8 * NTK * 32 * 4 <= RING_BYTES, "token phase B LDS");
    LAS float* rsc_all = (LAS float*)(lds + RSCR_OFF); LAS float* rsc = rsc_all + wave * (SLOTS * 32);
    LAS int* bcnt = (LAS int*)(lds + RSCR_OFF + 8 * SLOTS * 32 * 4); LAS int* bbase = bcnt + 32;
    LAS float* red = (LAS float*)(lds + RED_OFF);
    const float* mods = (const float*)(ws + WS_MODS) + (size_t)l * 9 * 6144; const float* gn = a.in[6] + (size_t)l * 4 * DM;
    const bf16* AP = (const bf16*)(ws + WS_AP); bf16* XB = (bf16*)(ws + WS_XB); unsigned char* H8 = ws + WS_H8;
    int* cnt = (int*)(ws + WS_CTL) + CW_CNT + l * 32 * 64; int* list = (int*)(ws + WS_LIST);
    int* texp = (int*)(ws + WS_RT); int* tpos = (int*)(ws + WS_RT + RT_STRIDE); float* tgate = (float*)(ws + WS_RT + 2 * RT_STRIDE);
    const float* br = a.in[15] + l * NE;
    const int nrows = l == 0 ? T : NB * SEQ;
    bf16x8 Bh[8], Bl[8];
    { const float* wr = a.in[14] + (size_t)l * DM * NE + (size_t)(128 * wave + 8 * (lane >> 5)) * NE + (lane & 31);
#pragma unroll
      for (int s2 = 0; s2 < 8; ++s2) { u32x4 wh, wl;
#pragma unroll
        for (int jj = 0; jj < 4; ++jj) { const float w0 = wr[(size_t)(16 * s2 + 2 * jj) * NE], w1 = wr[(size_t)(16 * s2 + 2 * jj + 1) * NE];
            const unsigned ph = pk2(w0, w1); wh[jj] = ph; wl[jj] = pk2(w0 - bflo(ph), w1 - bfhi(ph)); }
        Bh[s2] = __builtin_bit_cast(bf16x8, wh); Bl[s2] = __builtin_bit_cast(bf16x8, wl); } }
#define TOKB_ROW(r0_) (l == 0 ? (r0_) : ((r0_) >> 11) * RPB + ((r0_) & 2047))
    const int per_wave = (nrows + NGW - 1) / NGW, nchunk = (per_wave + SLOTS - 1) / SLOTS;
    for (int ch = 0; ch < nchunk; ++ch) {
        const int rbeg = gw + ch * SLOTS * NGW;
        const int nsl = per_wave - ch * SLOTS < SLOTS ? per_wave - ch * SLOTS : SLOTS;
        const int nit = (nsl + RPI - 1) / RPI;
        if (tid < 32) bcnt[tid] = 0;
        int ns = 0;
        RawBf nav, nrb; Row nrf;
        { const int r0c = rbeg < nrows ? rbeg : gw; const int rowp = TOKB_ROW(r0c);
          nav = ld_raw_bf16(AP + (size_t)rowp * DM, lane); nrb = nav; if (l == 0) nrf = ld_row_f32(src_row(a, rowp), lane); else nrb = ld_raw_bf16(XB + (size_t)rowp * DM, lane); }
        for (int it = 0; it < nit; ++it) {
#pragma unroll
          for (int j = 0; j < RPI; ++j) {
            const int s = it * RPI + j, r0 = rbeg + s * NGW; const bool valid = s < nsl && r0 < nrows;
            if (valid) {
                ns = s + 1;
                const int row = TOKB_ROW(r0);
                const int b = row / RPB, t = row % RPB; const float* mod = mods + (size_t)(t < SEQ ? b : 8) * 6144;
                const Row av = cvt_raw(nav); Row res; if (l == 0) res = nrf; else res = cvt_raw(nrb);
                { const int nr0 = (s + 1 < nsl && r0 + NGW < nrows) ? r0 + NGW : r0, nrow = TOKB_ROW(nr0);
                  nav = ld_raw_bf16(AP + (size_t)nrow * DM, lane); if (l == 0) nrf = ld_row_f32(src_row(a, nrow), lane); else nrb = ld_raw_bf16(XB + (size_t)nrow * DM, lane); }
                const float rs1 = row_rs(av);
                const Row G1 = ld_row_f32(gn + DM, lane), GT = ld_row_f32(mod + 2048, lane); Row x1;
#pragma unroll
                for (int jj = 0; jj < 4; ++jj) x1.v[jj] = res.v[jj] + GT.v[jj] * (av.v[jj] * rs1 * G1.v[jj]);
                st_row_bf16(XB + (size_t)row * DM, lane, x1);
                const Row h2 = norm_mod(x1, row_rs(x1), gn + 2 * DM, mod + 3072, mod + 4096, lane);
                { unsigned* q8 = (unsigned*)(H8 + (size_t)row * DM) + lane;
#pragma unroll
                  for (int jj = 0; jj < 4; ++jj) q8[64 * jj] = pack4_fp8(h2.v[jj].x, h2.v[jj].y, h2.v[jj].z, h2.v[jj].w); }
#pragma unroll
                for (int jj = 0; jj < 4; ++jj) { const unsigned h0 = pk2(h2.v[jj].x, h2.v[jj].y), h1 = pk2(h2.v[jj].z, h2.v[jj].w);
                    const unsigned l0 = pk2(h2.v[jj].x - bflo(h0), h2.v[jj].y - bfhi(h0)), l1 = pk2(h2.v[jj].z - bflo(h1), h2.v[jj].w - bfhi(h1));
                    *(LAS u32x2*)(lds + (8 * j + wave) * ROWB + (4 * lane + 256 * jj) * 2) = (u32x2){h0, h1};
                    *(LAS u32x2*)(lds + TILE_LO + (8 * j + wave) * ROWB + (4 * lane + 256 * jj) * 2) = (u32x2){l0, l1}; }
            }
          }
            LDS_WAIT(); __syncthreads();
            { f32x16 acc = {};
              const int mrow = (lane & 31) < NTK ? (lane & 31) : (lane & 31) - 8;
              const LAS unsigned char* arow = lds + mrow * ROWB + (128 * wave + 8 * (lane >> 5)) * 2;
#pragma unroll
              for (int s2 = 0; s2 < 8; ++s2) { const bf16x8 ah = *(const LAS bf16x8*)(arow + 32 * s2), al = *(const LAS bf16x8*)(arow + TILE_LO + 32 * s2);
                  acc = __builtin_amdgcn_mfma_f32_32x32x16_bf16(ah, Bh[s2], acc, 0, 0, 0);
                  acc = __builtin_amdgcn_mfma_f32_32x32x16_bf16(ah, Bl[s2], acc, 0, 0, 0);
                  acc = __builtin_amdgcn_mfma_f32_32x32x16_bf16(al, Bh[s2], acc, 0, 0, 0); }
#pragma unroll
              for (int r = 0; r < 4 * RPI; ++r) red[(wave * NTK + 8 * (r >> 2) + 4 * (lane >> 5) + (r & 3)) * 32 + (lane & 31)] = acc[r]; }
            LDS_WAIT(); __syncthreads();
            for (int idx = tid; idx < NTK * 32; idx += 512) { const int pt = idx >> 5, e = idx & 31; float lg = br[e];
#pragma unroll
                for (int w = 0; w < 8; ++w) lg += red[(w * NTK + pt) * 32 + e];
                rsc_all[(pt & 7) * (SLOTS * 32) + (it * RPI + (pt >> 3)) * 32 + e] = lg; }
        }
        LDS_WAIT(); __syncthreads();
        int ti[4]; float tg[4]; int lr[4];
        if (lane < ns) {
            float v[32];
#pragma unroll
            for (int q = 0; q < 8; ++q) { const f32x4 w = *(const LAS f32x4*)(rsc + lane * 32 + 4 * q); v[4 * q] = w.x; v[4 * q + 1] = w.y; v[4 * q + 2] = w.z; v[4 * q + 3] = w.w; }
            unsigned taken = 0u; float tv[4];
#pragma unroll
            for (int k = 0; k < 4; ++k) { float best = -3.0e38f; int bi = 0;
#pragma unroll
                for (int e = 0; e < 32; ++e) { const bool ok = !((taken >> e) & 1u) && v[e] > best; best = ok ? v[e] : best; bi = ok ? e : bi; }
                taken |= 1u << bi; tv[k] = best; ti[k] = bi; }
            const float e1 = expf(tv[1] - tv[0]), e2 = expf(tv[2] - tv[0]), e3 = expf(tv[3] - tv[0]), inv = 1.0f / (1.0f + e1 + e2 + e3);
            tg[0] = inv; tg[1] = e1 * inv; tg[2] = e2 * inv; tg[3] = e3 * inv;
#pragma unroll
            for (int k = 0; k < 4; ++k) lr[k] = __hip_atomic_fetch_add(bcnt + ti[k], 1, __ATOMIC_RELAXED, __HIP_MEMORY_SCOPE_WORKGROUP);
        }
        LDS_WAIT(); __syncthreads();
        if (tid < 32) { const int n = bcnt[tid]; bbase[tid] = n ? atomicAdd(cnt + tid * 64, n) : 0; }
        LDS_WAIT(); __syncthreads();
        if (lane < ns) { const int row = TOKB_ROW(rbeg + lane * NGW);
#pragma unroll
            for (int k = 0; k < 4; ++k) { const int pos = bbase[ti[k]] + lr[k]; list[(size_t)ti[k] * CAP + pos] = row; texp[row * 4 + k] = ti[k]; tpos[row * 4 + k] = pos; tgate[row * 4 + k] = tg[k]; } }
        __syncthreads();
    }
#undef TOKB_ROW
}
__device__ __forceinline__ void conv_range(const Args& a, unsigned char* ws, LAS unsigned char* lds, int l, int which, int lo, int hi, int lane, int wave, int widx, int nw) {
    __syncthreads(); LAS float* scr = (LAS float*)(lds + wave * 8448);
    if (which == 0) for (int it = lo + widx; it < hi; it += nw) { const int m = l * 32 + (it >> 9); transpose_item_f8<1, false>(a.in[16] + (size_t)m * DM * 2048, DM, 2048, ws + WS_W1 + (size_t)m * 2048 * DM, scr, it & 511, lane); }
    else for (int it = lo + widx; it < hi; it += nw) { const int m = l * 32 + (it >> 8); transpose_item_f8<0, false>(a.in[18] + (size_t)m * DM * DM, DM, DM, ws + WS_W2 + (size_t)m * DM * DM, scr, it & 255, lane); }
    __syncthreads();
}
__device__ __forceinline__ int idle_index(int units, int G, int c, int& n_idle) { const int rounds = (units + G - 1) / G, last = units - (rounds - 1) * G; n_idle = G - last; return c >= last ? c - last : -1; }
__device__ __forceinline__ int early_items(int l, int G) { int ni; idle_index(l == 0 ? 288 : 432, G, 0, ni); const int x = ni * 8 * (l == 0 ? EARLY_A : EARLY_B); return x < 32 * 512 ? x : 32 * 512; }
__device__ __forceinline__ void moe_tables(unsigned char* ws, LAS unsigned char* lds, int l, int tid) {
    LAS int* tab = (LAS int*)(lds + TAB_OFF);
    __syncthreads();
    if (tid == 0) { const int* cnt = (const int*)(ws + WS_CTL) + CW_CNT + l * 32 * 64; int tb = 0;
        for (int e = 0; e < 32; ++e) { const int n = __hip_atomic_load(cnt + e * 64, __ATOMIC_RELAXED, __HIP_MEMORY_SCOPE_AGENT); tab[e] = n; tab[32 + e] = tb; tb += (n + 255) >> 8; }
        tab[64] = tb; tab[65] = tb; }
    __syncthreads();
}
__device__ __forceinline__ void phase_tok_c(const Args& a, unsigned char* ws, LAS unsigned char* lds, int l, int lane, int gw, int NGW) {
    const LAS int* tab = (const LAS int*)(lds + TAB_OFF);
    const float* mods = (const float*)(ws + WS_MODS); const float* gn = a.in[6] + (size_t)l * 4 * DM;
    const unsigned char* Y = ws + WS_Y; bf16* XB = (bf16*)(ws + WS_XB); bf16* H = (bf16*)(ws + WS_H);
    const i32x4* texp = (const i32x4*)(ws + WS_RT); const i32x4* tpos = (const i32x4*)(ws + WS_RT + RT_STRIDE); const f32x4* tgate = (const f32x4*)(ws + WS_RT + 2 * RT_STRIDE);
    const int nrows = l == 0 ? T : NB * SEQ;
    if (gw >= nrows) return;
#define TOKC_ROW(r0_) (l == 0 ? (r0_) : ((r0_) >> 11) * RPB + ((r0_) & 2047))
    int rowc = TOKC_ROW(gw);
    i32x4 ex = texp[rowc], ps = tpos[rowc]; f32x4 gt = tgate[rowc];
    RawF8 y0 = ld_raw_fp8(Y + (size_t)(tab[32 + ex[0]] * 256 + ps[0]) * DM, lane), y1 = ld_raw_fp8(Y + (size_t)(tab[32 + ex[1]] * 256 + ps[1]) * DM, lane);
    RawF8 y2 = ld_raw_fp8(Y + (size_t)(tab[32 + ex[2]] * 256 + ps[2]) * DM, lane), y3 = ld_raw_fp8(Y + (size_t)(tab[32 + ex[3]] * 256 + ps[3]) * DM, lane);
    RawBf xr = ld_raw_bf16(XB + (size_t)rowc * DM, lane);
    int r1 = gw + NGW < nrows ? gw + NGW : gw, rown = TOKC_ROW(r1);
    i32x4 exn = texp[rown], psn = tpos[rown]; f32x4 gtn = tgate[rown];
    for (int r0 = gw; r0 < nrows; r0 += NGW) {
        const int row = rowc;
        const int b = row / RPB, t = row % RPB, mr = t < SEQ ? b : 8; const float* mod = mods + ((size_t)l * 9 + mr) * 6144;
        const RawF8 c0 = y0, c1 = y1, c2 = y2, c3 = y3; const RawBf cx = xr; const f32x4 cg = gt;
        y0 = ld_raw_fp8(Y + (size_t)(tab[32 + exn[0]] * 256 + psn[0]) * DM, lane); y1 = ld_raw_fp8(Y + (size_t)(tab[32 + exn[1]] * 256 + psn[1]) * DM, lane);
        y2 = ld_raw_fp8(Y + (size_t)(tab[32 + exn[2]] * 256 + psn[2]) * DM, lane); y3 = ld_raw_fp8(Y + (size_t)(tab[32 + exn[3]] * 256 + psn[3]) * DM, lane);
        xr = ld_raw_bf16(XB + (size_t)rown * DM, lane);
        rowc = rown; gt = gtn;
        { const int r2 = r0 + 2 * NGW < nrows ? r0 + 2 * NGW : r0; rown = TOKC_ROW(r2); exn = texp[rown]; psn = tpos[rown]; gtn = tgate[rown]; }
        Row f;
        { const Row a0 = cvt_raw(c0), a1 = cvt_raw(c1), a2 = cvt_raw(c2), a3 = cvt_raw(c3);
#pragma unroll
          for (int j = 0; j < 4; ++j) f.v[j] = (a0.v[j] * cg[0] + a1.v[j] * cg[1]) + (a2.v[j] * cg[2] + a3.v[j] * cg[3]); }
        const float rs = row_rs(f);
        const Row x1 = cvt_raw(cx), G3 = ld_row_f32(gn + 3 * DM, lane), GT = ld_row_f32(mod + 5120, lane); Row x2;
#pragma unroll
        for (int j = 0; j < 4; ++j) x2.v[j] = x1.v[j] + GT.v[j] * (f.v[j] * rs * G3.v[j]);
        if (l == 0) {
            st_row_bf16(XB + (size_t)row * DM, lane, x2);
            const float* mod1 = mods + ((size_t)9 + mr) * 6144;
            const Row h = norm_mod(x2, row_rs(x2), a.in[6] + 4 * DM, mod1, mod1 + 1024, lane);
            st_row_bf16(H + (size_t)row * DM, lane, h);
        } else {
            st_row_f32(a.out + ((size_t)b * SEQ + t) * DM, lane, x2);
        }
    }
#undef TOKC_ROW
}
__device__ __forceinline__ void phase_dbg_out(const Args& a, unsigned char* ws, int from_x, int lane, int gw, int NGW) {
    const bf16* XB = (const bf16*)(ws + WS_XB);
    for (int r0 = gw; r0 < NB * SEQ; r0 += NGW) { const int row = (r0 >> 11) * RPB + (r0 & 2047);
        const Row x = from_x ? ld_row_f32(a.in[0] + (size_t)r0 * DM, lane) : ld_row_bf16(XB + (size_t)row * DM, lane); st_row_f32(a.out + (size_t)r0 * DM, lane, x); }
}

constexpr int LAST_PH = DBG_STAGE == 0 ? NPH - 1 : DBG_STAGE == 1 ? -1 : DBG_STAGE == 2 ? 6 : DBG_STAGE == 3 ? 9 : 14;
template <int l>
__device__ __forceinline__ void layer_phases(const Args& args, unsigned char* ws, LAS unsigned char* lds, unsigned char* lds_raw, const XcdBarrier& bar, int lo, int hi,
                                             int tid, int lane, int wave, int G, int bx, int vcu, int gw, int NGW, int gtid, int NGT) {
    constexpr bool ONE = (MK_N_LAUNCHES == 1);
#define IN(k) (lo <= (k) && (k) < hi)
#define SEAM(k) do { if (ONE && IN((k) + 1)) { xcd_barrier(bar); if (DBL_BAR) xcd_barrier(bar); } PROBE_STAMP(k); } while (0)
        constexpr int P = 2 + 8 * l;
        constexpr int nq = l == 0 ? NQA : NQB;
        if (IN(P) && P <= LAST_PH) {
            pg8::Gemm g{(const pg8::bf16_t*)(ws + WS_H), (const pg8::bf16_t*)(ws + (l == 0 ? WS_WQA : WS_WQB)), T, nq, DM};
            pg8::StaticOrder S; S.init(T, nq, G, bx);
            if constexpr (l == 0) { pg8::EpiRopeA E{(pg8::bf16_t*)(ws + WS_QKV), (const float*)(ws + WS_ROPE), (const float*)(ws + WS_ROPE) + 1024};
                for (int rep = 0; rep < NREP(P); ++rep) pg8::gemm_phase<pg8::EpiRopeA, pg8::StaticOrder, true, true, false>(lds, g, S, E); }
            else { pg8::EpiStore E{(pg8::bf16_t*)(ws + WS_QKV), nq, nullptr, 0, 1.0f};
                for (int rep = 0; rep < NREP(P); ++rep) pg8::gemm_phase<pg8::EpiStore, pg8::StaticOrder, true, true, false>(lds, g, S, E); }
            if (W1_LATE && l == 1) { int ni; const int ii = idle_index(432, G, bx, ni); if (ii >= 0) conv_range(args, ws, lds, 1, 0, 0, early_items(1, G), lane, wave, ii * 8 + wave, ni * 8); }
            SEAM(P);
        }
        if (IN(P + 1) && P + 1 <= LAST_PH) { if constexpr (l == 1) { phase_qkfix_b(args, ws, gtid, NGT); SEAM(P + 1); } }
        if (IN(P + 2) && P + 2 <= LAST_PH) { for (int rep = 0; rep < NREP(P + 2); ++rep) { if (l == 0) phase_attn_a(args, ws, (char*)lds_raw, vcu, G); else phase_attn_b(args, ws, (char*)lds_raw, vcu, G); __syncthreads(); } SEAM(P + 2); }
        if (IN(P + 3) && P + 3 <= LAST_PH) {
            pg8::Gemm g{(const pg8::bf16_t*)(ws + WS_AO), (const pg8::bf16_t*)(ws + (l == 0 ? WS_WOA : WS_WOB)), T, DM, DM};
            pg8::StaticOrder S; S.init(l == 0 ? T : NB * SEQ, DM, G, bx, l);
            pg8::EpiStore E{(pg8::bf16_t*)(ws + WS_AP), DM, nullptr, 0, 1.0f};
            for (int rep = 0; rep < NREP(P + 3); ++rep) pg8::gemm_phase<pg8::EpiStore, pg8::StaticOrder, true, true, false>(lds, g, S, E);
            if (W1_LATE && l == 0) { int ni; const int ii = idle_index(288, G, bx, ni); if (ii >= 0) conv_range(args, ws, lds, 0, 0, 0, early_items(0, G), lane, wave, ii * 8 + wave, ni * 8); }
            SEAM(P + 3);
        }
        if (IN(P + 4) && P + 4 <= LAST_PH) {
            phase_tok_b(args, ws, lds, l, tid, lane, wave, gw, NGW);
            if (W1_LATE) conv_range(args, ws, lds, l, 0, early_items(l, G), 32 * 512, lane, wave, gw, NGW);
            SEAM(P + 4); }
        if (IN(P + 5) && P + 5 <= LAST_PH) {
            moe_tables(ws, lds, l, tid);
            pg8::Gemm g{(const pg8::bf16_t*)(ws + WS_H8), (const pg8::bf16_t*)(ws + WS_W1 + (size_t)l * NE * 2048 * DM), T, 2048, DM / 2};
            pg8::MoeOrder S{(const LAS int*)(lds + TAB_OFF), 8, G, vcu, (const int*)(ws + WS_LIST), CAP};
            pg8::EpiSwiglu8 E{ws + WS_ACT, args.in[17] + (size_t)l * NE * 2048, 1.0f / WSCALE};
#if defined(EPI_NULL) && EPI_NULL
            pg8::gemm_phase<pg8::EpiSwiglu8, pg8::MoeOrder, MOE_ALIGN, true, true, true>(lds, g, S, E);
            if (NREP(P + 5) == 2) { __syncthreads(); pg8::EpiNull EN{}; pg8::MoeOrder S2 = S; S2.same = (EPI_NULL == 2); pg8::gemm_phase<pg8::EpiNull, pg8::MoeOrder, MOE_ALIGN, true, true, true>(lds, g, S2, EN); }
#else
            for (int rep = 0; rep < NREP(P + 5); ++rep) pg8::gemm_phase<pg8::EpiSwiglu8, pg8::MoeOrder, MOE_ALIGN, true, true, true>(lds, g, S, E);
#endif
            if (W1_LATE) conv_range(args, ws, lds, l, 1, 0, 32 * 256, lane, wave, gw, NGW);
            SEAM(P + 5);
        }
        if (IN(P + 6) && P + 6 <= LAST_PH) {
            moe_tables(ws, lds, l, tid);
            pg8::Gemm g{(const pg8::bf16_t*)(ws + WS_ACT), (const pg8::bf16_t*)(ws + WS_W2 + (size_t)l * NE * DM * DM), T, DM, DM / 2};
            pg8::MoeOrder S{(const LAS int*)(lds + TAB_OFF), 4, G, vcu, (const int*)(ws + WS_LIST), CAP};
            pg8::EpiStore8 E{ws + WS_Y, DM, args.in[19] + (size_t)l * NE * DM, DM, 1.0f / WSCALE};
            for (int rep = 0; rep < NREP(P + 6); ++rep) pg8::gemm_phase<pg8::EpiStore8, pg8::MoeOrder, MOE_ALIGN, true, false, true>(lds, g, S, E);
            SEAM(P + 6);
        }
        if (IN(P + 7) && P + 7 <= LAST_PH) { moe_tables(ws, lds, l, tid); phase_tok_c(args, ws, lds, l, lane, gw, NGW); if (l == 1 && NREP(P + 7) == 2) phase_tok_c(args, ws, lds, l, lane, gw, NGW); if (l == 0) SEAM(P + 7); }
    #undef IN
#undef SEAM
}

__global__ void __launch_bounds__(512, 2) fwd(Args args) {
    extern __shared__ __attribute__((aligned(16))) unsigned char lds_raw[];
    LAS unsigned char* lds = (LAS unsigned char*)lds_raw;
    const int tid = threadIdx.x, lane = tid & 63, wave = __builtin_amdgcn_readfirstlane(tid >> 6);
    const int G = gridDim.x, bx = blockIdx.x, vcu = (G % 8 == 0) ? (bx % 8) * (G / 8) + bx / 8 : bx;
    const int gw = vcu * 8 + wave, NGW = G * 8, gtid = vcu * 512 + tid, NGT = G * 512;
    unsigned char* ws = args.ws;
    volatile LAS unsigned* MISC = (volatile LAS unsigned*)(lds + MISC_OFF);
    if (tid < 64) MISC[tid] = 0u;
    __syncthreads();
    constexpr bool ONE = (MK_N_LAUNCHES == 1);
    XcdBarrier bar; bar.bar = (unsigned*)(ws + WS_CTL) + CW_BAR; bar.x = 0; bar.st = nullptr;
    if (ONE) bar = xcd_barrier_post((unsigned*)(ws + WS_CTL) + CW_BAR, MISC + 8);
    const int lo = args.ph_lo, hi = args.ph_hi;
    if (PROBE_ON && bx == 0 && tid == 0) { volatile LAS unsigned* pm_ = (volatile LAS unsigned*)(lds + MISC_OFF) + 16; pm_[0] = (unsigned)__builtin_amdgcn_s_memrealtime(); pm_[1] = 0u; }
#define IN(k) (lo <= (k) && (k) < hi)
#define SEAM(k) do { if (ONE && IN((k) + 1)) { xcd_barrier(bar); if (DBL_BAR) xcd_barrier(bar); } PROBE_STAMP(k); } while (0)

    if (IN(0) && 0 <= LAST_PH) { for (int rep = 0; rep < NREP(0); ++rep) { phase_pro_a(args, ws, lds, tid, lane, wave, vcu, G); __syncthreads(); } SEAM(0); }
#if defined(STREAM_TEST) && STREAM_TEST
    { unsigned t0_ = 0; if (bx == 0 && tid == 0) t0_ = (unsigned)__builtin_amdgcn_s_memrealtime();
      const size_t n4a = (size_t)2 * 32 * 1024 * 2048 / 4, n4b = (size_t)2 * 32 * 1024 * 1024 / 4;
      unsigned* dst = (unsigned*)(ws + (size_t)1100 * MiB);
      for (size_t i = (size_t)gtid; i < n4a + n4b; i += (size_t)NGT) { const f32x4 v = i < n4a ? ((const f32x4*)args.in[16])[i] : ((const f32x4*)args.in[18])[i - n4a]; dst[i] = pack4_fp8(v.x * 32.f, v.y * 32.f, v.z * 32.f, v.w * 32.f); }
      xcd_barrier(bar);
      if (bx == 0 && tid == 0) { volatile LAS unsigned* pm_ = (volatile LAS unsigned*)(lds + MISC_OFF) + 16; pm_[2] = (unsigned)__builtin_amdgcn_s_memrealtime() - t0_; } }
#endif
    if (IN(1) && 1 <= LAST_PH) { for (int rep = 0; rep < NREP(1); ++rep) phase_pro_b(args, ws, lane, gw, NGW); SEAM(1); }
    layer_phases<0>(args, ws, lds, lds_raw, bar, lo, hi, tid, lane, wave, G, bx, vcu, gw, NGW, gtid, NGT);
    layer_phases<1>(args, ws, lds, lds_raw, bar, lo, hi, tid, lane, wave, G, bx, vcu, gw, NGW, gtid, NGT);
#if defined(STREAM_TEST) && STREAM_TEST
    { if (bx == 0 && tid == 0) { volatile LAS unsigned* pm_ = (volatile LAS unsigned*)(lds + MISC_OFF) + 16; const unsigned t0_ = (unsigned)__builtin_amdgcn_s_memrealtime(), d_ = pm_[2];
            while ((unsigned)__builtin_amdgcn_s_memrealtime() - t0_ < d_) __builtin_amdgcn_s_sleep(8); } __syncthreads(); }
#endif
    if (PROBE_ON) {
        PROBE_STAMP(NPH - 1);
        if (bx == 0 && tid == 0) { volatile LAS unsigned* pm_ = (volatile LAS unsigned*)(lds + MISC_OFF) + 16; const unsigned t0_ = (unsigned)__builtin_amdgcn_s_memrealtime(), d_ = pm_[1];
            while ((unsigned)__builtin_amdgcn_s_memrealtime() - t0_ < d_) __builtin_amdgcn_s_sleep(8); }
        __syncthreads();
    }
    if (DBG_STAGE != 0 && IN(NPH - 1)) {
        if (ONE) xcd_barrier(bar);
        phase_dbg_out(args, ws, DBG_STAGE == 1, lane, gw, NGW);
    }
#undef IN
#undef SEAM
}

extern "C" void kernel_launch(void* const* d_in, const int* in_sizes, int n_in, void* d_out, int out_size, void* d_ws, size_t ws_size, hipStream_t stream) {
    static int grid = 0;
    if (grid == 0) {
        if (n_in != NIN || in_sizes[0] != NB * SEQ * DM || out_size != NB * SEQ * DM || ws_size < WS_END) {
            fprintf(stderr, "kernel_launch: built for %d inputs, x/out of %d floats, >= %zu bytes of workspace; got n_in %d, in0 %d, out %d, ws %zu; nothing launched\n", NIN, NB * SEQ * DM, (size_t)WS_END, n_in, n_in > 0 ? in_sizes[0] : -1, out_size, ws_size); grid = -1; return; }
        int dev = 0, cus = 0, per_cu = 0;
        if (hipGetDevice(&dev) != hipSuccess || hipDeviceGetAttribute(&cus, hipDeviceAttributeMultiprocessorCount, dev) != hipSuccess) { fprintf(stderr, "kernel_launch: hipGetDevice / hipDeviceGetAttribute failed\n"); grid = -1; return; }
        if (hipFuncSetAttribute((const void*)fwd, hipFuncAttributeMaxDynamicSharedMemorySize, LDS_BYTES) != hipSuccess) { fprintf(stderr, "kernel_launch: hipFuncSetAttribute failed\n"); grid = -1; return; }
        if (hipOccupancyMaxActiveBlocksPerMultiprocessor(&per_cu, (const void*)fwd, 512, LDS_BYTES) != hipSuccess || per_cu < 1)
            fprintf(stderr, "kernel_launch: note: the occupancy query reports %d workgroups per CU\n", per_cu);
        (void)hipGetLastError();
        grid = cus;
    }
    if (grid < 0) return;
    if (hipMemsetAsync((char*)d_ws + WS_CTL, 0, CTL_ZERO_BYTES, stream) != hipSuccess) { fprintf(stderr, "kernel_launch: hipMemsetAsync failed\n"); return; }
    Args a{};
    for (int i = 0; i < NIN; ++i) a.in[i] = (const float*)d_in[i];
    a.out = (float*)d_out; a.ws = (unsigned char*)d_ws;
    for (int li = 0; li < MK_N_LAUNCHES; ++li) {
        a.ph_lo = (MK_N_LAUNCHES == 1) ? 0 : li; a.ph_hi = (MK_N_LAUNCHES == 1) ? NPH : li + 1;
        hipLaunchKernelGGL(fwd, dim3(grid), dim3(512), LDS_BYTES, stream, a);
        const hipError_t le = hipPeekAtLastError();
        if (le != hipSuccess) { fprintf(stderr, "kernel_launch: launch %d failed: %s\n", li, hipGetErrorName(le)); break; }
    }
}
```

```cpp
#include <hip/hip_runtime.h>
#include <cstdio>
#include <cstdint>

#define LAS __attribute__((address_space(3)))
#define GAS __attribute__((address_space(1)))
typedef unsigned short bf16;
typedef short bf16x8 __attribute__((ext_vector_type(8)));
typedef short s16x4 __attribute__((ext_vector_type(4)));
typedef float f32x4 __attribute__((ext_vector_type(4)));
typedef float f32x16 __attribute__((ext_vector_type(16)));
typedef unsigned u32x4 __attribute__((ext_vector_type(4)));
typedef unsigned u32x2 __attribute__((ext_vector_type(2)));
typedef int i32x4 __attribute__((ext_vector_type(4)));

constexpr int NB = 8, SEQ = 2048, CTXL = 256, DM = 1024, RPB = SEQ + CTXL, T = NB * RPB;
constexpr int NQA = 1280, NQB = 1536;
constexpr int NE = 32, TOPK = 4, CAP = T;
constexpr float EPS = 1e-6f;
constexpr int NIN = 20;

#define MK_N_LAUNCHES 1
#define DBG_STAGE 0
#define DUP_MASK 0
#define DBG_PROBE 0
#define DBL_BAR 0
#define SHADOW_MODE 0
#define MODS_WORTH 6
#define STREAM_TEST 0
#define W1_LATE 1
#define W1_FIRST 0
#define TOKB_RPI 3
#define EPI_NULL 0
#define MOE_ALIGN true
#define CONV_A 0
#define CONV_B 24
#define CONV_MOD 3
#define CONV_ON 2
#define QKB_FUSE 1
#define BGW 0
#define WQ2 0
#define WQ4 0
#define WQ5 0
#define CONV_MOD_A 5
#define FLAT_BAR 0
#define EARLY_A 6
#define EARLY_B 6
namespace pg8 {
#define PG8_LAS __attribute__((address_space(3)))
typedef unsigned short bf16_t;
typedef short bf16x8 __attribute__((ext_vector_type(8)));
typedef float f32x4 __attribute__((ext_vector_type(4)));
typedef unsigned u32x4 __attribute__((ext_vector_type(4)));
typedef int i32x4_t __attribute__((ext_vector_type(4)));
constexpr int BM = 256, BK = 64, HALF = 128, HTB = HALF * BK * 2  , STAGE_BYTES = 8 * HTB, NXCD = 8, WGM = 8;

__host__ __device__ __forceinline__ int lds_byte(int r, int c) { const int st = (r >> 4) * 2 + (c >> 5), rr = r & 15, cc = c & 31, ob = rr * 64 + cc * 2; return st * 1024 + (ob ^ (((ob >> 9) & 1) << 5)); }
__host__ __device__ __forceinline__ void stage_rc(int b, int& R, int& C) { const int st = b / 1024, sb = b % 1024, swz = sb ^ (((sb >> 9) & 1) << 5); R = (st >> 1) * 16 + swz / 64; C = (st & 1) * 32 + (swz % 64) / 2; }
__host__ __device__ __forceinline__ int perm32(int rho) { const int n = rho >> 4, i = rho & 15; return 8 * (i >> 2) + 4 * n + (i & 3); }

struct Unit { int pm, pn, cn, e, pos0, ne; };
struct Gemm { const bf16_t* A; const bf16_t* Bt; int M, N, K; };

struct StaticOrder {
    int nM, nN, nwg, G, c, skip9;
    __host__ __device__ void init(int M, int N, int G_, int c_, int skip9_ = 0) { nM = M / BM; nN = N / BM; nwg = nM * nN; G = G_; c = c_; skip9 = skip9_; }
    __host__ __device__ bool next(int i, Unit& u) const {
        const long L = (long)i * G + c; if (L >= nwg) return false;
        int wgid = (int)L; { const int q = nwg / NXCD, r = nwg % NXCD, xcd = wgid % NXCD, off = wgid / NXCD; wgid = (xcd < r ? xcd * (q + 1) : r * (q + 1) + (xcd - r) * q) + off; }
        const int nig = WGM * nN, gid = wgid / nig, fm = gid * WGM, gsz = (nM - fm) < WGM ? (nM - fm) : WGM;
        u.pm = fm + ((wgid % nig) % gsz); u.pn = (wgid % nig) / gsz; if (skip9) u.pm += u.pm / 8; u.cn = u.pn; u.e = 0; u.pos0 = 0; u.ne = 0; return true;
    }
    __device__ __forceinline__ void a_ready(const Unit&) const {}
    __device__ __forceinline__ void done(const Unit&) const {}
};

template <class Epi, class Sched, bool ALIGN_EPI = false, bool SP2 = false, bool GATHER = false, bool F8 = false>
__device__ __forceinline__ void gemm_phase(PG8_LAS unsigned char* lds, const Gemm g, const Sched& S, const Epi& E) {
    const int tid = threadIdx.x, wid = __builtin_amdgcn_readfirstlane(tid >> 6), lane = tid & 63, wr = wid >> 2, wc = wid & 3, fr = lane & 15, fq = lane >> 4;
    const int K = g.K, nt = K / BK;
    unsigned voffA[2], voffB[2]; int RA[2], CA[2];
#pragma unroll
    for (int i = 0; i < 2; ++i) { int R, C; stage_rc(tid * 16 + i * 8192, R, C); const int Rb = Epi::PERM ? ((R & ~31) + perm32(R & 31)) : R; RA[i] = R; CA[i] = C;
        voffA[i] = (unsigned)(R * K + C) * 2u; voffB[i] = (unsigned)(Rb * K + C) * 2u; }
    unsigned oc0[2], oc1[2], on0[2], on1[2];
#define PG8_GOFF(u, o0, o1) do { _Pragma("unroll") for (int _i = 0; _i < 2; ++_i) { if constexpr (GATHER) { \
        const int lim_ = (u).ne - 1; int p0_ = (u).pos0 + RA[_i], p1_ = p0_ + HALF; p0_ = p0_ < lim_ ? p0_ : lim_; p1_ = p1_ < lim_ ? p1_ : lim_; \
        const int t0_ = S.list[(size_t)(u).e * S.cap + p0_], t1_ = S.list[(size_t)(u).e * S.cap + p1_]; \
        (o0)[_i] = (unsigned)(t0_ * K + CA[_i]) * 2u; (o1)[_i] = (unsigned)(t1_ * K + CA[_i]) * 2u; } else { (o0)[_i] = voffA[_i]; (o1)[_i] = voffA[_i]; } } } while (0)
    const size_t kstep = (size_t)(BK * 2);
    const size_t hstep = (size_t)HALF * K * 2; const size_t hstepA = GATHER ? (size_t)0 : hstep;
    const size_t tstep = 2 * hstep;
    const unsigned ldsw = (unsigned)wid * 1024u;
    const int aoff = lds_byte(wr * 64 + fr, fq * 8), boff = lds_byte(wc * 32 + fr, fq * 8);
#define PG8_SA(b, h) (((b) * 2 + (h)) * HTB)
#define PG8_SB(b, h) ((4 + (b) * 2 + (h)) * HTB)
#define PG8_STAGE(bufoff, gbase, voff) do { _Pragma("unroll") for (int _i = 0; _i < 2; ++_i) \
        __builtin_amdgcn_global_load_lds((const unsigned*)((const char*)(gbase) + (voff)[_i]), (PG8_LAS unsigned*)(lds + (bufoff) + ldsw + _i * 8192), 16, 0, 0); } while (0)
#define PG8_LDA(dst, b, h) do { _Pragma("unroll") for (int m = 0; m < 4; ++m) _Pragma("unroll") for (int k = 0; k < 2; ++k) dst[m][k] = *(const PG8_LAS bf16x8*)(lds + PG8_SA(b, h) + aoff + m * 2048 + k * 1024); } while (0)
#define PG8_LDB(dst, b, h) do { _Pragma("unroll") for (int n = 0; n < 2; ++n) _Pragma("unroll") for (int k = 0; k < 2; ++k) dst[n][k] = *(const PG8_LAS bf16x8*)(lds + PG8_SB(b, h) + boff + n * 2048 + k * 1024); } while (0)
#define PG8_CAT8(x0, x1) __builtin_shufflevector(__builtin_bit_cast(i32x4_t, (x0)), __builtin_bit_cast(i32x4_t, (x1)), 0, 1, 2, 3, 4, 5, 6, 7)
#define PG8_MMA(ai, bj, At, Bt) do { __builtin_amdgcn_s_setprio(1); if constexpr (F8) { asm volatile("s_nop 1" ::: "memory"); _Pragma("unroll") for (int m = 0; m < 4; ++m) _Pragma("unroll") for (int n = 0; n < 2; ++n) \
        asm volatile("v_mfma_scale_f32_16x16x128_f8f6f4 %0, %1, %2, %0, %3, %3 op_sel_hi:[0,0,0]" : "+v"(acc[ai][bj][m][n]) : "v"(PG8_CAT8(Bt[n][0], Bt[n][1])), "v"(PG8_CAT8(At[m][0], At[m][1])), "v"(0x7f7f7f7f)); } \
    else { _Pragma("unroll") for (int m = 0; m < 4; ++m) _Pragma("unroll") for (int n = 0; n < 2; ++n) _Pragma("unroll") for (int k = 0; k < 2; ++k) \
        acc[ai][bj][m][n] = __builtin_amdgcn_mfma_f32_16x16x32_bf16(Bt[n][k], At[m][k], acc[ai][bj][m][n], 0, 0, 0); } __builtin_amdgcn_s_setprio(0); } while (0)
#define PG8_WAIT_V(n) asm volatile("s_waitcnt vmcnt(" #n ")" ::: "memory")
#define PG8_WAIT_L(n) asm volatile("s_waitcnt lgkmcnt(" #n ")" ::: "memory")
#define PG8_BAR __builtin_amdgcn_s_barrier()
#define PG8_SCHED __builtin_amdgcn_sched_barrier(0)
    Unit cur, nxt; int ui = 0;
    if (!S.next(0, cur)) return;
    f32x4 acc[2][2][4][2];
#pragma unroll
    for (int a = 0; a < 2; ++a)
#pragma unroll
        for (int b = 0; b < 2; ++b)
#pragma unroll
            for (int m = 0; m < 4; ++m)
#pragma unroll
                for (int n = 0; n < 2; ++n) acc[a][b][m][n] = (f32x4){0.f, 0.f, 0.f, 0.f};
    bf16x8 At[4][2], B0[2][2], B1[2][2];
    const char* cA = (const char*)g.A + (GATHER ? (size_t)0 : (size_t)cur.pm * tstep); PG8_GOFF(cur, oc0, oc1); const char* cB = (const char*)g.Bt + (size_t)cur.pn * tstep;
    S.a_ready(cur);
    if constexpr (SP2) {
        PG8_STAGE(PG8_SB(0, 0), cB, voffB); PG8_STAGE(PG8_SB(0, 1), cB + hstep, voffB); PG8_STAGE(PG8_SA(0, 0), cA, oc0); PG8_STAGE(PG8_SA(0, 1), cA + hstepA, oc1);
        if (wr == 1) PG8_BAR;
        PG8_WAIT_V(2); PG8_BAR;
        PG8_STAGE(PG8_SB(1, 0), cB + kstep, voffB); PG8_STAGE(PG8_SA(1, 0), cA + kstep, oc0); PG8_STAGE(PG8_SB(1, 1), cB + hstep + kstep, voffB);
        PG8_WAIT_V(6); PG8_BAR;
    } else {
        PG8_STAGE(PG8_SB(0, 0), cB, voffB); PG8_STAGE(PG8_SA(0, 0), cA, oc0); PG8_STAGE(PG8_SB(0, 1), cB + hstep, voffB); PG8_STAGE(PG8_SA(0, 1), cA + hstepA, oc1);
        if (wr == 1) PG8_BAR;
        PG8_WAIT_V(4); PG8_BAR;
        PG8_STAGE(PG8_SB(1, 0), cB + kstep, voffB); PG8_STAGE(PG8_SA(1, 0), cA + kstep, oc0); PG8_STAGE(PG8_SB(1, 1), cB + hstep + kstep, voffB);
        PG8_WAIT_V(6); PG8_BAR;
    }
    for (;;) {
        E.stage(lds + 132096 + (ui & 1) * 1024, cur, wid, lane);
        const bool has_next = S.next(ui + 1, nxt);
        const char* nA = (has_next && !GATHER) ? (const char*)g.A + (size_t)nxt.pm * tstep : cA;
        if constexpr (GATHER) { if (has_next && wid < 4) { const int lim_ = nxt.ne - 1; int p_ = nxt.pos0 + wid * 64 + lane; p_ = p_ < lim_ ? p_ : lim_; __builtin_amdgcn_global_load_lds((const unsigned*)(S.list + (size_t)nxt.e * S.cap + p_), (PG8_LAS unsigned*)(lds + 134144 + wid * 256), 4, 0, 0); } } const char* nB = has_next ? (const char*)g.Bt + (size_t)nxt.pn * tstep : cB;
        for (int t = 0; t < nt; t += 2) {
            const bool last = (t == nt - 2);
            const char* a1 = cA + (size_t)(t + 1) * kstep;
            const char* a2 = last ? nA : cA + (size_t)(t + 2) * kstep; const char* b2 = last ? nB : cB + (size_t)(t + 2) * kstep;
            const char* a3 = a2 + kstep; const char* b3 = b2 + kstep;
            if (last) { _Pragma("unroll") for (int _i = 0; _i < 2; ++_i) { if (GATHER && has_next) { const volatile PG8_LAS int* ids_ = (const volatile PG8_LAS int*)(lds + 134144); const int t0_ = ids_[RA[_i]], t1_ = ids_[RA[_i] + HALF]; on0[_i] = (unsigned)(t0_ * K + CA[_i]) * 2u; on1[_i] = (unsigned)(t1_ * K + CA[_i]) * 2u; } else { on0[_i] = oc0[_i]; on1[_i] = oc1[_i]; } } }
            const unsigned s0[2] = {last ? on0[0] : oc0[0], last ? on0[1] : oc0[1]}, s1[2] = {last ? on1[0] : oc1[0], last ? on1[1] : oc1[1]};
            if (last && has_next) S.a_ready(nxt);
            if constexpr (SP2) {
            PG8_LDB(B0, 0, 0); PG8_LDB(B1, 0, 1); PG8_SCHED; PG8_LDA(At, 0, 0); PG8_STAGE(PG8_SA(1, 1), a1 + hstepA, oc1);
            PG8_WAIT_V(8); PG8_WAIT_L(0); PG8_BAR; PG8_MMA(0, 0, At, B0); PG8_MMA(0, 1, At, B1); PG8_BAR; PG8_SCHED;
            PG8_LDA(At, 0, 1); PG8_STAGE(PG8_SB(0, 0), b2, voffB); PG8_STAGE(PG8_SB(0, 1), b2 + hstep, voffB); PG8_STAGE(PG8_SA(0, 0), a2, s0);
            PG8_WAIT_V(8); PG8_WAIT_L(0); PG8_BAR; PG8_MMA(1, 0, At, B0); PG8_MMA(1, 1, At, B1); PG8_BAR; PG8_SCHED;
            PG8_LDB(B0, 1, 0); PG8_LDB(B1, 1, 1); PG8_SCHED; PG8_LDA(At, 1, 0); PG8_STAGE(PG8_SA(0, 1), a2 + hstepA, s1);
            PG8_WAIT_V(8); PG8_WAIT_L(0); PG8_BAR; PG8_MMA(0, 0, At, B0); PG8_MMA(0, 1, At, B1); PG8_BAR; PG8_SCHED;
            PG8_LDA(At, 1, 1); PG8_STAGE(PG8_SB(1, 0), b3, voffB); PG8_STAGE(PG8_SB(1, 1), b3 + hstep, voffB); PG8_STAGE(PG8_SA(1, 0), a3, s0);
            PG8_WAIT_V(8); PG8_WAIT_L(0); PG8_BAR; PG8_MMA(1, 0, At, B0); PG8_MMA(1, 1, At, B1); PG8_BAR; PG8_SCHED;
            } else {
            PG8_LDB(B0, 0, 0); PG8_SCHED; PG8_LDA(At, 0, 0); PG8_STAGE(PG8_SA(1, 1), a1 + hstepA, oc1);
            PG8_WAIT_L(8); PG8_BAR; PG8_WAIT_L(0); PG8_MMA(0, 0, At, B0); PG8_BAR; PG8_SCHED;
            PG8_LDB(B1, 0, 1); PG8_STAGE(PG8_SB(0, 0), b2, voffB);
            PG8_BAR; PG8_WAIT_L(0); PG8_MMA(0, 1, At, B1); PG8_BAR;
            PG8_LDA(At, 0, 1); PG8_STAGE(PG8_SA(0, 0), a2, s0);
            PG8_BAR; PG8_WAIT_L(0); PG8_MMA(1, 0, At, B0); PG8_BAR; PG8_SCHED;
            PG8_STAGE(PG8_SB(0, 1), b2 + hstep, voffB);
            PG8_WAIT_V(6); PG8_BAR; PG8_MMA(1, 1, At, B1); PG8_BAR;
            PG8_LDB(B0, 1, 0); PG8_SCHED; PG8_LDA(At, 1, 0); PG8_STAGE(PG8_SA(0, 1), a2 + hstepA, s1);
            PG8_WAIT_L(8); PG8_BAR; PG8_WAIT_L(0); PG8_MMA(0, 0, At, B0); PG8_BAR; PG8_SCHED;
            PG8_LDB(B1, 1, 1); PG8_STAGE(PG8_SB(1, 0), b3, voffB);
            PG8_BAR; PG8_WAIT_L(0); PG8_MMA(0, 1, At, B1); PG8_BAR;
            PG8_LDA(At, 1, 1); PG8_STAGE(PG8_SA(1, 0), a3, s0);
            PG8_BAR; PG8_WAIT_L(0); PG8_MMA(1, 0, At, B0); PG8_BAR; PG8_SCHED;
            PG8_STAGE(PG8_SB(1, 1), b3 + hstep, voffB);
            PG8_WAIT_V(6); PG8_BAR; PG8_MMA(1, 1, At, B1); PG8_BAR;
            }
        }
        if constexpr (ALIGN_EPI) { if (wr == 0) PG8_BAR; }
        if constexpr (F8) asm volatile("s_nop 15\n\ts_nop 15" ::: "memory");
        if constexpr (!Epi::AFTER_DRAIN) { E(acc, cur, wr, wc, fr, fq, (const PG8_LAS float*)(lds + 132096 + (ui & 1) * 1024)); S.done(cur); }
        if (!has_next) break;
#pragma unroll
        for (int a = 0; a < 2; ++a)
#pragma unroll
            for (int b = 0; b < 2; ++b)
#pragma unroll
                for (int m = 0; m < 4; ++m)
#pragma unroll
                    for (int n = 0; n < 2; ++n) acc[a][b][m][n] = (f32x4){0.f, 0.f, 0.f, 0.f};
        cur = nxt; cA = nA; cB = nB; ++ui;
        _Pragma("unroll") for (int _i = 0; _i < 2; ++_i) { oc0[_i] = on0[_i]; oc1[_i] = on1[_i]; }
        if constexpr (ALIGN_EPI) { if (wr == 1) PG8_BAR; }
    }
    PG8_WAIT_V(0);
    if constexpr (!ALIGN_EPI) { if (wr == 0) PG8_BAR; }
    PG8_BAR;
    if constexpr (Epi::AFTER_DRAIN) { E.fused(acc, cur, wr, wc, fr, fq, lds, wid, lane); S.done(cur); }
#undef PG8_GOFF
#undef PG8_CAT8
#undef PG8_SA
#undef PG8_SB
#undef PG8_STAGE
#undef PG8_LDA
#undef PG8_LDB
#undef PG8_MMA
#undef PG8_WAIT_V
#undef PG8_WAIT_L
#undef PG8_BAR
#undef PG8_SCHED
}
}

namespace pg8 {
__device__ __forceinline__ unsigned cvt_pk_bf16(float lo, float hi) { unsigned r; asm volatile("v_cvt_pk_bf16_f32 %0, %1, %2" : "=v"(r) : "v"(lo), "v"(hi)); return r; }
struct EpiStore {
    static constexpr bool PERM = true, AFTER_DRAIN = false;
    bf16_t* O; int ldc; const float* bias; int bias_stride; float ws;
    __device__ __forceinline__ void stage(PG8_LAS unsigned char*, const Unit&, int, int) const {}
    __device__ __forceinline__ void operator()(const f32x4 (&acc)[2][2][4][2], const Unit& u, int wr, int wc, int fr, int fq, const PG8_LAS float* lb) const {
        const int row0 = u.pm * BM + wr * 64 + fr, col0 = u.cn * BM + wc * 32 + 8 * fq;
        f32x4 bv[2][2];
#pragma unroll
        for (int bj = 0; bj < 2; ++bj)
#pragma unroll
            for (int n = 0; n < 2; ++n) bv[bj][n] = bias ? *(const f32x4*)(bias + (size_t)u.e * bias_stride + col0 + bj * HALF + 4 * n) : (f32x4){0.f, 0.f, 0.f, 0.f};
#pragma unroll
        for (int ai = 0; ai < 2; ++ai)
#pragma unroll
            for (int m = 0; m < 4; ++m) { bf16_t* rowp = O + (size_t)(row0 + ai * HALF + m * 16) * ldc + col0;
#pragma unroll
                for (int bj = 0; bj < 2; ++bj) { const f32x4 v0 = acc[ai][bj][m][0] * ws + bv[bj][0], v1 = acc[ai][bj][m][1] * ws + bv[bj][1];
                    u32x4 w; w.x = cvt_pk_bf16(v0[0], v0[1]); w.y = cvt_pk_bf16(v0[2], v0[3]); w.z = cvt_pk_bf16(v1[0], v1[1]); w.w = cvt_pk_bf16(v1[2], v1[3]);
                    *(u32x4*)(rowp + bj * HALF) = w; } }
    }
};
struct EpiRopeA {
    static constexpr bool PERM = true, AFTER_DRAIN = false;
    bf16_t* O; const PG8_LAS float* rc; const PG8_LAS float* rs;
    __device__ __forceinline__ void stage(PG8_LAS unsigned char*, const Unit&, int, int) const {}
    __device__ __forceinline__ void operator()(const f32x4 (&acc)[2][2][4][2], const Unit& u, int wr, int wc, int fr, int fq, const PG8_LAS float* lb) const {
        typedef unsigned u32x2v __attribute__((ext_vector_type(2)));
        const int row0 = u.pm * BM + wr * 64 + fr, vcol0 = u.cn * BM + wc * 32 + 8 * fq;
        const bool lat = (u.pm % 9) != 8;
#pragma unroll
        for (int ai = 0; ai < 2; ++ai)
#pragma unroll
            for (int m = 0; m < 4; ++m) { const int row = row0 + ai * HALF + m * 16, t = row % 2304, pos = (wc & 1) ? (t & 63) : ((t >> 6) & 31);
                const f32x4 cs = *(const PG8_LAS f32x4*)(rc + pos * 16 + 4 * fq), sn = *(const PG8_LAS f32x4*)(rs + pos * 16 + 4 * fq);
                bf16_t* rowp = O + (size_t)row * 1280;
#pragma unroll
                for (int bj = 0; bj < 2; ++bj) { const f32x4 v0 = acc[ai][bj][m][0], v1 = acc[ai][bj][m][1]; const int vc = vcol0 + bj * HALF;
                    if (u.cn < 4 || bj == 0) { const f32x4 o1 = lat ? v0 * cs - v1 * sn : v0, o2 = lat ? v1 * cs + v0 * sn : v1; const int a1 = (vc & ~63) + (wc & 1) * 32 + 4 * fq;
                        u32x2v w1, w2; w1.x = cvt_pk_bf16(o1[0], o1[1]); w1.y = cvt_pk_bf16(o1[2], o1[3]); w2.x = cvt_pk_bf16(o2[0], o2[1]); w2.y = cvt_pk_bf16(o2[2], o2[3]);
                        *(u32x2v*)(rowp + a1) = w1; *(u32x2v*)(rowp + a1 + 16) = w2; }
                    else { u32x4 w; w.x = cvt_pk_bf16(v0[0], v0[1]); w.y = cvt_pk_bf16(v0[2], v0[3]); w.z = cvt_pk_bf16(v1[0], v1[1]); w.w = cvt_pk_bf16(v1[2], v1[3]); *(u32x4*)(rowp + vc) = w; } } }
    }
};
struct EpiQkB {
    static constexpr bool PERM = true, AFTER_DRAIN = false;
    bf16_t* O; const float* rc; const float* rs; const float* gq; const float* gk; PG8_LAS float* part;
    __device__ __forceinline__ void stage(PG8_LAS unsigned char*, const Unit&, int, int) const {}
    __device__ __forceinline__ void operator()(const f32x4 (&acc)[2][2][4][2], const Unit& u, int wr, int wc, int fr, int fq, const PG8_LAS float*) const {
        typedef unsigned u32x2v __attribute__((ext_vector_type(2)));
        const int row0 = u.pm * BM + wr * 64 + fr;
        if (u.cn == 5) {
            const int col0 = u.cn * BM + wc * 32 + 8 * fq;
#pragma unroll
            for (int ai = 0; ai < 2; ++ai)
#pragma unroll
                for (int m = 0; m < 4; ++m) { bf16_t* rowp = O + (size_t)(row0 + ai * HALF + m * 16) * 1536 + col0;
#pragma unroll
                    for (int bj = 0; bj < 2; ++bj) { const f32x4 v0 = acc[ai][bj][m][0], v1 = acc[ai][bj][m][1];
                        u32x4 w; w.x = cvt_pk_bf16(v0[0], v0[1]); w.y = cvt_pk_bf16(v0[2], v0[3]); w.z = cvt_pk_bf16(v1[0], v1[1]); w.w = cvt_pk_bf16(v1[2], v1[3]);
                        *(u32x4*)(rowp + bj * HALF) = w; } }
            return;
        }
#pragma unroll
        for (int ai = 0; ai < 2; ++ai)
#pragma unroll
            for (int m = 0; m < 4; ++m)
#pragma unroll
                for (int bj = 0; bj < 2; ++bj) { const f32x4 v0 = acc[ai][bj][m][0], v1 = acc[ai][bj][m][1];
                    float s = (v0[0] * v0[0] + v0[1] * v0[1]) + (v0[2] * v0[2] + v0[3] * v0[3]) + (v1[0] * v1[0] + v1[1] * v1[1]) + (v1[2] * v1[2] + v1[3] * v1[3]);
                    s += __shfl_xor(s, 16); s += __shfl_xor(s, 32);
                    if (fq == 0) part[((wr * 16 + (ai * 4 + m) * 2 + bj) * 16 + fr) * 4 + wc] = s; }
        asm volatile("s_waitcnt lgkmcnt(0)" ::: "memory"); __builtin_amdgcn_s_barrier();
        const int axis = wc >> 1, jp = 4 * (wc & 1) + fq, d1 = axis * 64 + 4 * jp;
        const bool isk = u.cn == 4; const float* gn = isk ? gk : gq;
        const f32x4 g1 = *(const f32x4*)(gn + d1), g2 = *(const f32x4*)(gn + d1 + 32);
#pragma unroll
        for (int ai = 0; ai < 2; ++ai)
#pragma unroll
            for (int m = 0; m < 4; ++m) { const int row = row0 + ai * HALF + m * 16, t = row % 2304; const bool lat = t < 2048; const int pos = axis ? (t & 63) : (t >> 6);
                if (!lat && !isk) continue;
                f32x4 cs = (f32x4){1.f, 1.f, 1.f, 1.f}, sn = (f32x4){0.f, 0.f, 0.f, 0.f};
                if (lat) { cs = *(const f32x4*)(rc + pos * 32 + 4 * jp); sn = *(const f32x4*)(rs + pos * 32 + 4 * jp); }
                bf16_t* rowp = O + (size_t)row * 1536 + u.cn * BM + d1;
#pragma unroll
                for (int bj = 0; bj < 2; ++bj) { const f32x4 p = *(const PG8_LAS f32x4*)(part + ((wr * 16 + (ai * 4 + m) * 2 + bj) * 16 + fr) * 4);
                    const float rn = 1.0f / sqrtf(((p[0] + p[1]) + (p[2] + p[3])) * (1.0f / 128.0f) + 1e-6f);
                    const f32x4 x1 = acc[ai][bj][m][0] * rn * g1, x2 = acc[ai][bj][m][1] * rn * g2;
                    const f32x4 o1 = x1 * cs - x2 * sn, o2 = x2 * cs + x1 * sn;
                    u32x2v w1, w2; w1.x = cvt_pk_bf16(o1[0], o1[1]); w1.y = cvt_pk_bf16(o1[2], o1[3]); w2.x = cvt_pk_bf16(o2[0], o2[1]); w2.y = cvt_pk_bf16(o2[2], o2[3]);
                    *(u32x2v*)(rowp + bj * HALF) = w1; *(u32x2v*)(rowp + bj * HALF + 32) = w2; } }
    }
};
__device__ __forceinline__ unsigned pack4_fp8(float a, float b, float c, float d) { int w = 0; w = __builtin_amdgcn_cvt_pk_fp8_f32(a, b, w, false); w = __builtin_amdgcn_cvt_pk_fp8_f32(c, d, w, true); return (unsigned)w; }
struct EpiStore8 {
    static constexpr bool PERM = true, AFTER_DRAIN = false;
    unsigned char* O; int ldc; const float* bias; int bias_stride; float ws;
    __device__ __forceinline__ void stage(PG8_LAS unsigned char* lb, const Unit& u, int wid, int lane) const {
        if (wid < 4) __builtin_amdgcn_global_load_lds((const unsigned*)(bias + (size_t)u.e * bias_stride + u.cn * BM + wid * 64 + lane), (PG8_LAS unsigned*)(lb + wid * 256), 4, 0, 0); }
    __device__ __forceinline__ void operator()(const f32x4 (&acc)[2][2][4][2], const Unit& u, int wr, int wc, int fr, int fq, const PG8_LAS float* lb) const {
        typedef unsigned u32x2v __attribute__((ext_vector_type(2)));
        const int row0 = u.pm * BM + wr * 64 + fr, col0 = u.cn * BM + wc * 32 + 8 * fq;
        f32x4 bv[2][2];
#pragma unroll
        for (int bj = 0; bj < 2; ++bj)
#pragma unroll
            for (int n = 0; n < 2; ++n) bv[bj][n] = *(const PG8_LAS f32x4*)(lb + bj * HALF + wc * 32 + 8 * fq + 4 * n);
#pragma unroll
        for (int ai = 0; ai < 2; ++ai)
#pragma unroll
            for (int m = 0; m < 4; ++m) { unsigned char* rowp = O + (size_t)(row0 + ai * HALF + m * 16) * ldc + col0;
#pragma unroll
                for (int bj = 0; bj < 2; ++bj) { typedef float f32x2v __attribute__((ext_vector_type(2)));
                    const f32x4 a0 = acc[ai][bj][m][0], a1 = acc[ai][bj][m][1], b0 = bv[bj][0], b1 = bv[bj][1];
                    const f32x2v p0 = (f32x2v){a0[0], a0[1]} * ws + (f32x2v){b0[0], b0[1]}, p1 = (f32x2v){a0[2], a0[3]} * ws + (f32x2v){b0[2], b0[3]};
                    const f32x2v p2 = (f32x2v){a1[0], a1[1]} * ws + (f32x2v){b1[0], b1[1]}, p3 = (f32x2v){a1[2], a1[3]} * ws + (f32x2v){b1[2], b1[3]};
                    u32x2v w; w.x = pack4_fp8(p0.x, p0.y, p1.x, p1.y); w.y = pack4_fp8(p2.x, p2.y, p3.x, p3.y);
                    *(u32x2v*)(rowp + bj * HALF) = w; } }
    }
};
struct EpiSwiglu8 {
    static constexpr bool PERM = true, AFTER_DRAIN = false;
    unsigned char* O; const float* b1; float ws;
    __device__ __forceinline__ void stage(PG8_LAS unsigned char* lb, const Unit& u, int wid, int lane) const {
        if (wid < 4) __builtin_amdgcn_global_load_lds((const unsigned*)(b1 + (size_t)u.e * 2048 + (wid >> 1) * 1024 + u.cn * 128 + (wid & 1) * 64 + lane), (PG8_LAS unsigned*)(lb + wid * 256), 4, 0, 0); }
    __device__ __forceinline__ void operator()(const f32x4 (&acc)[2][2][4][2], const Unit& u, int wr, int wc, int fr, int fq, const PG8_LAS float* lb) const {
        typedef unsigned u32x2v __attribute__((ext_vector_type(2)));
        const int row0 = u.pm * BM + wr * 64 + fr, col0 = u.cn * 128 + wc * 32 + 8 * fq;
        f32x4 bg[2], bl[2];
#pragma unroll
        for (int n = 0; n < 2; ++n) { bg[n] = *(const PG8_LAS f32x4*)(lb + wc * 32 + 8 * fq + 4 * n); bl[n] = *(const PG8_LAS f32x4*)(lb + 128 + wc * 32 + 8 * fq + 4 * n); }
#pragma unroll
        for (int ai = 0; ai < 2; ++ai)
#pragma unroll
            for (int m = 0; m < 4; ++m) { unsigned char* rowp = O + (size_t)(row0 + ai * HALF + m * 16) * 1024 + col0; float a[8];
#pragma unroll
                for (int n = 0; n < 2; ++n) { const f32x4 g = acc[ai][0][m][n] * ws + bg[n], l = acc[ai][1][m][n] * ws + bl[n];
#pragma unroll
                    for (int h = 0; h < 2; ++h) {
                        typedef float f32x2v __attribute__((ext_vector_type(2)));
                        const f32x2v gg = {fminf(g[2 * h], 7.0f), fminf(g[2 * h + 1], 7.0f)};
                        const f32x2v ll = {fminf(fmaxf(l[2 * h], -7.0f), 7.0f), fminf(fmaxf(l[2 * h + 1], -7.0f), 7.0f)};
                        const f32x2v t = gg * (-1.702f * 1.4426950408889634f);
                        const f32x2v e = {__builtin_amdgcn_exp2f(t.x), __builtin_amdgcn_exp2f(t.y)};
                        const f32x2v d = e + 1.0f;
                        const f32x2v sg = {__builtin_amdgcn_rcpf(d.x), __builtin_amdgcn_rcpf(d.y)};
                        const f32x2v y = (gg * sg) * (ll + 1.0f);
                        a[4 * n + 2 * h] = y.x; a[4 * n + 2 * h + 1] = y.y; } }
                u32x2v w; w.x = pack4_fp8(a[0], a[1], a[2], a[3]); w.y = pack4_fp8(a[4], a[5], a[6], a[7]);
                *(u32x2v*)rowp = w; }
    }
};
struct EpiNull {
    static constexpr bool PERM = true, AFTER_DRAIN = false;
    __device__ __forceinline__ void stage(PG8_LAS unsigned char*, const Unit&, int, int) const {}
    __device__ __forceinline__ void operator()(const f32x4 (&acc)[2][2][4][2], const Unit& u, int wr, int wc, int fr, int fq, const PG8_LAS float* lb) const {
#pragma unroll
        for (int ai = 0; ai < 2; ++ai)
#pragma unroll
            for (int m = 0; m < 4; ++m) asm volatile("" :: "v"(acc[ai][0][m][0]), "v"(acc[ai][1][m][1]), "v"(acc[ai][0][m][1]), "v"(acc[ai][1][m][0])); }
};
struct MoeOrder {
    const PG8_LAS int* tab; int nN, G, c; const int* list; int cap; int same;
    __device__ __forceinline__ bool next(int i, Unit& u) const {
        int L = i * G + c; const int TT = tab[65]; if (L >= TT * nN) return false;
        if (same) L = 0;
        const int lk = (int)(threadIdx.x & 31);
        const int e = __builtin_popcountll(__ballot(lk >= 1 && L >= tab[32 + lk] * nN) & 0xffffffffull);
        const int t0 = tab[32 + e], mt = tab[33 + e] - t0, local = L - t0 * nN, pml = local % mt, pnl = local / mt;
        u.pm = __builtin_amdgcn_readfirstlane(t0 + pml); u.pn = __builtin_amdgcn_readfirstlane(e * nN + pnl); u.cn = __builtin_amdgcn_readfirstlane(pnl);
        u.e = __builtin_amdgcn_readfirstlane(e); u.pos0 = __builtin_amdgcn_readfirstlane(pml * 256); u.ne = __builtin_amdgcn_readfirstlane(tab[e]); return true;
    }
    __device__ __forceinline__ void a_ready(const Unit&) const {}
    __device__ __forceinline__ void done(const Unit&) const {}
};
}

namespace att {
#define SBAR() __builtin_amdgcn_sched_barrier(0)
constexpr float THR = 8.f;
__device__ __forceinline__ int crow(int r, int hi) { return (r & 3) + 8 * (r >> 2) + 4 * hi; }
__device__ __forceinline__ unsigned cvtpk(float lo, float hi) { unsigned r; asm volatile("v_cvt_pk_bf16_f32 %0, %1, %2" : "=v"(r) : "v"(lo), "v"(hi)); return r; }
template <int D> struct Cst { static constexpr float SCALE = (D == 64) ? 0.125f : 0.088388347648318440f; };
template <int D> __device__ __forceinline__ int kswz(int row, int colB) {
    if constexpr (D == 128) return row * 256 + (colB ^ ((row & 15) << 4));
    else return row * 128 + (colB ^ (((row >> 1) & 7) << 4));
}
template <int D> __device__ __forceinline__ void partialSM(f32x16& p0, f32x16& p1, float& m_reg, float& mn, float& alpha) {
  constexpr float SCALE = Cst<D>::SCALE, C = SCALE * 1.4426950408889634f;
  float pmax = p0[0];
#pragma unroll
  for (int r = 1; r < 16; ++r) pmax = fmaxf(pmax, p0[r]);
#pragma unroll
  for (int r = 0; r < 16; ++r) pmax = fmaxf(pmax, p1[r]);
  { auto rr = __builtin_amdgcn_permlane32_swap(__float_as_uint(pmax), __float_as_uint(pmax), false, false);
    pmax = fmaxf(__uint_as_float(rr[0]), __uint_as_float(rr[1])); }
  if (__builtin_expect(__all(pmax - m_reg <= THR / SCALE), 1)) { mn = m_reg; alpha = 1.f; }
  else { mn = fmaxf(m_reg, pmax); alpha = __builtin_amdgcn_exp2f((m_reg - mn) * C); m_reg = mn; }
  const float mnC = -mn * C;
#pragma unroll
  for (int r = 0; r < 16; ++r) p0[r] = fmaf(p0[r], C, mnC);
#pragma unroll
  for (int r = 0; r < 16; ++r) p1[r] = fmaf(p1[r], C, mnC);
#pragma unroll
  for (int r = 0; r < 16; ++r) p0[r] = __builtin_amdgcn_exp2f(p0[r]);
}
__device__ __forceinline__ void finishSM(f32x16& p0, f32x16& p1, float alpha, float& l_reg, bf16x8& pa0, bf16x8& pa1, bf16x8& pa2, bf16x8& pa3) {
#pragma unroll
  for (int r = 0; r < 16; ++r) p1[r] = __builtin_amdgcn_exp2f(p1[r]);
  float ps = 0;
#pragma unroll
  for (int r = 0; r < 16; ++r) ps += p0[r];
#pragma unroll
  for (int r = 0; r < 16; ++r) ps += p1[r];
  { auto rr = __builtin_amdgcn_permlane32_swap(__float_as_uint(ps), __float_as_uint(ps), false, false);
    ps = __uint_as_float(rr[0]) + __uint_as_float(rr[1]); }
  l_reg = l_reg * alpha + ps;
#define PK4(P, BASE, OUT) do { unsigned a0 = cvtpk(P[BASE + 0], P[BASE + 1]), a1 = cvtpk(P[BASE + 2], P[BASE + 3]);   \
    unsigned b0 = cvtpk(P[BASE + 4], P[BASE + 5]), b1 = cvtpk(P[BASE + 6], P[BASE + 7]);                              \
    auto r0 = __builtin_amdgcn_permlane32_swap(a0, b0, false, false); auto r1 = __builtin_amdgcn_permlane32_swap(a1, b1, false, false); \
    u32x4 w = {r0[0], r1[0], r0[1], r1[1]}; OUT = *reinterpret_cast<bf16x8*>(&w); } while (0)
  PK4(p0, 0, pa0); PK4(p0, 8, pa1); PK4(p1, 0, pa2); PK4(p1, 8, pa3);
#undef PK4
}
__device__ __forceinline__ void wmask(f32x16& p0, f32x16& p1, int dq) {
#pragma unroll
  for (int r = 0; r < 16; ++r) { const int d0 = dq + (r & 3) + 8 * (r >> 2), d1 = d0 + 32;
    if (d0 > 128 || d0 < -128) p0[r] = -1e30f;
    if (d1 > 128 || d1 < -128) p1[r] = -1e30f; }
}
template <int D> __device__ __forceinline__ void qkt(f32x16& p0, f32x16& p1, const char* Ks, const bf16x8* qr, int r32, int hi) {
  p0 = f32x16{}; p1 = f32x16{};
#pragma unroll
  for (int d0 = 0; d0 < D / 16; ++d0) { const int cb = (d0 * 16 + hi * 8) * 2;
    bf16x8 b0 = *reinterpret_cast<const bf16x8*>(Ks + kswz<D>(r32, cb));
    bf16x8 b1 = *reinterpret_cast<const bf16x8*>(Ks + kswz<D>(32 + r32, cb));
    p0 = __builtin_amdgcn_mfma_f32_32x32x16_bf16(b0, qr[d0], p0, 0, 0, 0);
    p1 = __builtin_amdgcn_mfma_f32_32x32x16_bf16(b1, qr[d0], p1, 0, 0, 0); }
}
template <int D> __device__ __forceinline__ int v_st(int k, int c) { const int kk = (k & ~0xC) | ((k & 4) << 1) | ((k & 8) >> 1); return ((kk >> 3) * (D / 32) + (c >> 5)) * 512 + ((kk & 7) * 32 + (c & 31)) * 2; }
__device__ __forceinline__ int v_rd_base(int lane) { return ((lane & 3) << 3) | (((lane >> 2) & 3) << 6) | (((lane >> 4) & 1) << 5) | (((lane >> 5) & 1) << 8); }
template <int D> constexpr int v_rd_off(int d0, int ks, int half) { return ((2 * ks + half) * (D / 32) + d0) * 512; }
template <int OFF> __device__ __forceinline__ s16x4 tr_read(int vb) {
  s16x4 r; asm volatile("ds_read_b64_tr_b16 %0, %1 offset:%2" : "=&v"(r) : "v"(vb), "i"(OFF) : "memory"); return r;
}
template <int D, int D0> __device__ __forceinline__ void pv_one(f32x16& od, int vb, bf16x8 pa0, bf16x8 pa1, bf16x8 pa2, bf16x8 pa3) {
  const s16x4 l0 = tr_read<v_rd_off<D>(D0, 0, 0)>(vb), h0 = tr_read<v_rd_off<D>(D0, 0, 1)>(vb), l1 = tr_read<v_rd_off<D>(D0, 1, 0)>(vb), h1 = tr_read<v_rd_off<D>(D0, 1, 1)>(vb);
  const s16x4 l2 = tr_read<v_rd_off<D>(D0, 2, 0)>(vb), h2 = tr_read<v_rd_off<D>(D0, 2, 1)>(vb), l3 = tr_read<v_rd_off<D>(D0, 3, 0)>(vb), h3 = tr_read<v_rd_off<D>(D0, 3, 1)>(vb);
  asm volatile("s_waitcnt lgkmcnt(0)" ::: "memory"); SBAR();
#define PK(L, H) (bf16x8){L[0], L[1], L[2], L[3], H[0], H[1], H[2], H[3]}
  od = __builtin_amdgcn_mfma_f32_32x32x16_bf16(pa0, PK(l0, h0), od, 0, 0, 0);
  od = __builtin_amdgcn_mfma_f32_32x32x16_bf16(pa1, PK(l1, h1), od, 0, 0, 0);
  od = __builtin_amdgcn_mfma_f32_32x32x16_bf16(pa2, PK(l2, h2), od, 0, 0, 0);
  od = __builtin_amdgcn_mfma_f32_32x32x16_bf16(pa3, PK(l3, h3), od, 0, 0, 0);
#undef PK
}
template <int D> __device__ __forceinline__ void pv_all(f32x16* o, int vb, bf16x8 pa0, bf16x8 pa1, bf16x8 pa2, bf16x8 pa3) {
  pv_one<D, 0>(o[0], vb, pa0, pa1, pa2, pa3); pv_one<D, 1>(o[1], vb, pa0, pa1, pa2, pa3);
  if constexpr (D == 128) { pv_one<D, 2>(o[2], vb, pa0, pa1, pa2, pa3); pv_one<D, 3>(o[3], vb, pa0, pa1, pa2, pa3); }
}
template <int D> constexpr int attn_lds_bytes() { return 4 * 64 * D * 2 + 8 * 64 * 4; }

struct Conv { const float* w1; const float* w2; unsigned char* o1; unsigned char* o2; int next, end, stride, pend, scr, tick; };
constexpr float CONV_SCALE = 32.0f;
__device__ __forceinline__ void conv_decode(const Conv& c, int h, const float*& W, int& N, unsigned char*& WT, int& k0, int& n0, bool& m1) {
  if (h < 16384) { const int m = h >> 9, rem = h & 511, kb = ((rem >> 6) << 1) | (rem & 1), nb = (rem >> 1) & 31; W = c.w2 + (size_t)m * 1024 * 1024; N = 1024; WT = c.o2 + (size_t)m * 1024 * 1024; k0 = 64 * kb; n0 = 32 * nb; m1 = false; }
  else { const int g = h - 16384, m = 31 - (g >> 10), rem = g & 1023,
    kb = ((rem >> 7) << 1) | (rem & 1), nb = (rem >> 1) & 63; W = c.w1 + (size_t)m * 1024 * 2048; N = 2048; WT = c.o1 + (size_t)m * 2048 * 1024; k0 = 64 * kb; n0 = 32 * nb; m1 = true; }
}
__device__ __forceinline__ void conv_issue(const Conv& c, int h, LAS unsigned char* ldsl, int lane) {
  const float* W; int N, k0, n0; unsigned char* WT; bool m1; conv_decode(c, h, W, N, WT, k0, n0, m1);
  const float* g = W + (size_t)(k0 + (lane >> 3)) * N + n0 + 4 * (lane & 7);
#pragma unroll
  for (int i = 0; i < 8; ++i) __builtin_amdgcn_global_load_lds((const unsigned*)(g + (size_t)(8 * i) * N), (LAS unsigned*)(ldsl + c.scr + i * 1024), 16, 0, 2);
}
__device__ __forceinline__ void conv_finish(const Conv& c, int h, LAS unsigned char* ldsl, int lane) {
  const float* W; int N, k0, n0; unsigned char* WT; bool m1; conv_decode(c, h, W, N, WT, k0, n0, m1);
  const int n = lane & 31, kh = lane >> 5; int nn = n0 + n;
  if (m1) nn = (nn < 1024) ? ((nn >> 7) * 256 + (nn & 127)) : ((((nn - 1024) >> 7) * 256) + 128 + (nn & 127));
  const LAS float* sp = (const LAS float*)(ldsl + c.scr) + (kh * 32) * 32 + n;
  unsigned char* rowp = WT + (size_t)nn * 1024 + k0 + kh * 32;
#pragma unroll
  for (int hf = 0; hf < 2; ++hf) { float v[16];
#pragma unroll
    for (int kk = 0; kk < 16; kk += 2) { typedef float f32x2v __attribute__((ext_vector_type(2))); const f32x2v t = (f32x2v){sp[(hf * 16 + kk) * 32], sp[(hf * 16 + kk + 1) * 32]} * CONV_SCALE; v[kk] = t.x; v[kk + 1] = t.y; }
    u32x4 o; o.x = pg8::pack4_fp8(v[0], v[1], v[2], v[3]); o.y = pg8::pack4_fp8(v[4], v[5], v[6], v[7]); o.z = pg8::pack4_fp8(v[8], v[9], v[10], v[11]); o.w = pg8::pack4_fp8(v[12], v[13], v[14], v[15]);
    *(u32x4*)(rowp + hf * 16) = o; }
}
#ifndef CONV_MOD
#define CONV_MOD 1
#endif
#ifndef CONV_ON
#define CONV_ON 1
#endif
template <int NPL> __device__ __forceinline__ bool conv_mid(Conv& c, LAS unsigned char* ldsl, int lane, bool may_issue = true) {
  if (c.pend >= 0) { if constexpr (NPL == 4) asm volatile("s_waitcnt vmcnt(4)" ::: "memory"); else asm volatile("s_waitcnt vmcnt(2)" ::: "memory"); conv_finish(c, c.pend, ldsl, lane); }
  if (may_issue && c.next < c.end) { asm volatile("s_waitcnt lgkmcnt(0)" ::: "memory"); conv_issue(c, c.next, ldsl, lane); c.pend = c.next; c.next += c.stride; return true; }
  c.pend = -1; return false;
}
__device__ __forceinline__ void conv_drain(Conv& c, LAS unsigned char* ldsl, int lane) {
  for (;;) {
    if (c.pend >= 0) { asm volatile("s_waitcnt vmcnt(0)" ::: "memory"); conv_finish(c, c.pend, ldsl, lane); }
    if (c.next >= c.end) { c.pend = -1; break; }
    asm volatile("s_waitcnt lgkmcnt(0)" ::: "memory"); conv_issue(c, c.next, ldsl, lane); c.pend = c.next; c.next += c.stride;
  }
}
template <int D, bool MASK, int LD, bool QFIX = false, bool CONV = false, int CMOD = 1, int CON = 1>
__device__ __forceinline__ void attn_unit(const bf16* __restrict__ Qb, const bf16* __restrict__ Kb, const bf16* __restrict__ Vb, bf16* __restrict__ Ob,
                                          int nwin, int wstart, int cstart, int NT, int qpos0, float m0, float l0, char* lds,
                                          const float* qaux = nullptr, Conv* cv = nullptr, LAS unsigned char* ldsl = nullptr) {
  constexpr int ND0 = D / 16, NDO = D / 32, TPR = D / 8, RPP = 512 / TPR, NP = 64 / RPP, SHM_V = 64 * D * 2, SHM_K = 64 * D * 2, LDO = 1024;
  const int tid = threadIdx.x, wid = tid >> 6, lane = tid & 63, r32 = lane & 31, hi = lane >> 5;
  char* V_lds = lds; char* K_lds = lds + 2 * SHM_V;
  float* ws = (float*)(lds + 2 * SHM_V + 2 * SHM_K) + wid * 64; float* li_l = ws; float* al_l = ws + 32;
  float m_reg = m0, l_reg = l0; f32x16 o[NDO]; bf16x8 qr[ND0];
#pragma unroll
  for (int d = 0; d < NDO; ++d) o[d] = f32x16{};
  const bf16* Qw = Qb + (long)(wid * 32 + r32) * LD + hi * 8;
#pragma unroll
  for (int d0 = 0; d0 < ND0; ++d0) qr[d0] = *reinterpret_cast<const bf16x8*>(Qw + d0 * 16);
  if constexpr (QFIX) {
    static_assert(D == 128, "QFIX is the mixer-B (head dim 128) path");
    const float* rcos = qaux; const float* rsin = qaux + 2048; const float* qgain = qaux + 4096;
    float ss = 0.f;
#pragma unroll
    for (int d0 = 0; d0 < 8; ++d0)
#pragma unroll
      for (int j = 0; j < 8; ++j) { const float v = __builtin_bit_cast(float, (unsigned)(unsigned short)qr[d0][j] << 16); ss += v * v; }
    { auto rr = __builtin_amdgcn_permlane32_swap(__float_as_uint(ss), __float_as_uint(ss), false, false); ss = __uint_as_float(rr[0]) + __uint_as_float(rr[1]); }
    const float rn = 1.0f / sqrtf(ss * (1.0f / 128.0f) + 1e-6f);
    const int tq = qpos0 + wid * 32 + r32;
#pragma unroll
    for (int hf = 0; hf < 2; ++hf) { const int pos = hf ? (tq & 63) : ((tq >> 6) & 31);
#pragma unroll
      for (int dd = 0; dd < 2; ++dd) { const int d1 = hf * 4 + dd, d2 = d1 + 2, f0 = dd * 16 + hi * 8;
        float cs[8], sn[8], g1[8], g2[8];
#pragma unroll
        for (int q = 0; q < 2; ++q) { const f32x4 c = *(const f32x4*)(rcos + pos * 32 + f0 + 4 * q), z = *(const f32x4*)(rsin + pos * 32 + f0 + 4 * q);
          const f32x4 a = *(const f32x4*)(qgain + d1 * 16 + hi * 8 + 4 * q), b = *(const f32x4*)(qgain + d2 * 16 + hi * 8 + 4 * q);
#pragma unroll
          for (int j = 0; j < 4; ++j) { cs[4 * q + j] = c[j]; sn[4 * q + j] = z[j]; g1[4 * q + j] = a[j] * rn; g2[4 * q + j] = b[j] * rn; } }
        float o1[8], o2[8];
#pragma unroll
        for (int j = 0; j < 8; ++j) { const float x1 = __builtin_bit_cast(float, (unsigned)(unsigned short)qr[d1][j] << 16) * g1[j], x2 = __builtin_bit_cast(float, (unsigned)(unsigned short)qr[d2][j] << 16) * g2[j];
          o1[j] = x1 * cs[j] - x2 * sn[j]; o2[j] = x2 * cs[j] + x1 * sn[j]; }
        { u32x4 w = {cvtpk(o1[0], o1[1]), cvtpk(o1[2], o1[3]), cvtpk(o1[4], o1[5]), cvtpk(o1[6], o1[7])}; qr[d1] = *reinterpret_cast<bf16x8*>(&w); }
        { u32x4 w = {cvtpk(o2[0], o2[1]), cvtpk(o2[2], o2[3]), cvtpk(o2[4], o2[5]), cvtpk(o2[6], o2[7])}; qr[d2] = *reinterpret_cast<bf16x8*>(&w); } } }
  }
  const int sr = tid / TPR, sc = (tid % TPR) * 8;
  int vst[NP], kst[NP];
#pragma unroll
  for (int p = 0; p < NP; ++p) { vst[p] = v_st<D>(sr + p * RPP, sc); kst[p] = kswz<D>(sr + p * RPP, sc * 2); }
  const int vb0 = (int)(uintptr_t)V_lds + v_rd_base(lane);
  const int dqb = 4 * hi - (qpos0 + wid * 32 + r32);
  bf16x8 sv0[NP], sk0[NP], sv1[NP], sk1[NP];
#define KROW(j) ((j) < nwin ? wstart + 64 * (j) : cstart + 64 * ((j) - nwin))
#define SLOAD(SV, SK, j) do { const long rb_ = (long)KROW(j) + sr; _Pragma("unroll") for (int p = 0; p < NP; ++p) { \
    SV[p] = *reinterpret_cast<const bf16x8*>(Vb + (rb_ + p * RPP) * LD + sc); SK[p] = *reinterpret_cast<const bf16x8*>(Kb + (rb_ + p * RPP) * LD + sc); } } while (0)
#define SWRITE(b, SV, SK) do { _Pragma("unroll") for (int p = 0; p < NP; ++p) { *reinterpret_cast<bf16x8*>(V_lds + (b) * SHM_V + vst[p]) = SV[p]; \
    *reinterpret_cast<bf16x8*>(K_lds + (b) * SHM_K + kst[p]) = SK[p]; } } while (0)
#define SWAIT() do { if constexpr (NP == 2) asm volatile("s_waitcnt vmcnt(4)" ::: "memory"); else asm volatile("s_waitcnt vmcnt(2)" ::: "memory"); } while (0)
#define SWAITC() do { if constexpr (NP == 2) asm volatile("s_waitcnt vmcnt(12)" ::: "memory"); else asm volatile("s_waitcnt vmcnt(10)" ::: "memory"); } while (0)
#define RESC(a) do { if (__any((a) < 1.f)) { if (hi == 0) al_l[r32] = (a); asm volatile("s_waitcnt lgkmcnt(0)" ::: "memory"); \
    _Pragma("unroll") for (int d = 0; d < NDO; ++d) _Pragma("unroll") for (int r = 0; r < 16; ++r) o[d][r] *= al_l[crow(r, hi)]; } } while (0)
#define MASKT(PA, PB, j) do { if constexpr (MASK) { if ((j) < nwin) { const int k0_ = wstart + 64 * (j); if (k0_ - tqw > 65 || tqw - k0_ > 97) wmask(PA, PB, k0_ + dqb); } } } while (0)
  f32x16 pA0, pA1, pB0, pB1; float mnA, mnB, alA, alB; bf16x8 pa0, pa1, pa2, pa3;
  const int tqw = qpos0 + __builtin_amdgcn_readfirstlane(wid) * 32;
#define ACT(j) (!MASK || (j) >= nwin || (wstart + 64 * (j) <= tqw + 159 && wstart + 64 * (j) + 63 >= tqw - 128))
  bool actA, actB;
  SLOAD(sv0, sk0, 0); asm volatile("s_waitcnt vmcnt(0)" ::: "memory"); SWRITE(0, sv0, sk0); __syncthreads();
  actA = ACT(0);
  if (actA) { qkt<D>(pA0, pA1, K_lds, qr, r32, hi); MASKT(pA0, pA1, 0); partialSM<D>(pA0, pA1, m_reg, mnA, alA); } else alA = 1.f;
  SLOAD(sv1, sk1, 1); if (2 < NT) SLOAD(sv0, sk0, 2);
  SWAIT(); SWRITE(1, sv1, sk1); __syncthreads();
  for (int j = 1; j + 1 < NT; j += 2) {
    bool ciss = false; if constexpr (CONV) { { const bool on_ = ((cv->tick++) % CMOD) < CON; if (cv->pend >= 0 || on_) ciss = conv_mid<2 * NP>(*cv, ldsl, lane, on_); } SBAR(); }
    actB = ACT(j);
    SBAR(); if (actB) qkt<D>(pB0, pB1, K_lds + SHM_K, qr, r32, hi);
    if (actA) finishSM(pA0, pA1, alA, l_reg, pa0, pa1, pa2, pa3); SBAR();
    SLOAD(sv1, sk1, j + 2); SBAR();
    if (actA) pv_all<D>(o, vb0, pa0, pa1, pa2, pa3);
    if (actB) { MASKT(pB0, pB1, j); partialSM<D>(pB0, pB1, m_reg, mnB, alB); } else alB = 1.f;
    __syncthreads(); if (CONV && ciss) SWAITC(); else SWAIT(); SWRITE(0, sv0, sk0);
    RESC(alB); __syncthreads();
    actA = ACT(j + 1);
    SBAR(); if (actA) qkt<D>(pA0, pA1, K_lds, qr, r32, hi);
    if (actB) finishSM(pB0, pB1, alB, l_reg, pa0, pa1, pa2, pa3); SBAR();
    if (j + 3 < NT) SLOAD(sv0, sk0, j + 3); SBAR();
    if (actB) pv_all<D>(o, vb0 + SHM_V, pa0, pa1, pa2, pa3);
    if (actA) { MASKT(pA0, pA1, j + 1); partialSM<D>(pA0, pA1, m_reg, mnA, alA); } else alA = 1.f;
    __syncthreads(); SWAIT(); SWRITE(1, sv1, sk1);
    RESC(alA); __syncthreads();
  }
  actB = ACT(NT - 1);
  SBAR(); if (actB) qkt<D>(pB0, pB1, K_lds + SHM_K, qr, r32, hi);
  if (actA) finishSM(pA0, pA1, alA, l_reg, pa0, pa1, pa2, pa3); SBAR();
  if (actA) pv_all<D>(o, vb0, pa0, pa1, pa2, pa3);
  if (actB) { MASKT(pB0, pB1, NT - 1); partialSM<D>(pB0, pB1, m_reg, mnB, alB); } else alB = 1.f;
  __syncthreads(); RESC(alB);
  if (actB) { finishSM(pB0, pB1, alB, l_reg, pa0, pa1, pa2, pa3); SBAR();
    pv_all<D>(o, vb0 + SHM_V, pa0, pa1, pa2, pa3); }
#undef ACT
  if (hi == 0) li_l[r32] = l_reg; asm volatile("s_waitcnt lgkmcnt(0)" ::: "memory");
  float rli[16];
#pragma unroll
  for (int r = 0; r < 16; ++r) rli[r] = __builtin_amdgcn_rcpf(li_l[crow(r, hi)]);
  bf16* Ow = Ob + (long)(wid * 32) * LDO;
#pragma unroll
  for (int r = 0; r < 16; ++r) { const int orow = crow(r, hi);
#pragma unroll
    for (int d0 = 0; d0 < NDO; ++d0) { const float v = o[d0][r] * rli[r]; Ow[(long)orow * LDO + d0 * 32 + r32] = (bf16)(cvtpk(v, v) & 0xffffu); } }
#undef KROW
#undef SLOAD
#undef SWRITE
#undef SWAIT
#undef SWAITC
#undef RESC
#undef MASKT
}
}

#ifndef MK_N_LAUNCHES
#define MK_N_LAUNCHES 1
#endif
#ifndef DBG_STAGE
#define DBG_STAGE 0
#endif
#ifndef DUP_MASK
#define DUP_MASK 0
#endif
#define NREP(p) ((((DUP_MASK) >> (p)) & 1) ? 2 : 1)
#ifndef DBL_BAR
#define DBL_BAR 0
#endif
#ifndef DBG_PROBE
#define DBG_PROBE 0
#endif
#define PROBE_ON (((DBG_PROBE) >> 8) & 1)
#define PROBE_PH ((DBG_PROBE) & 0xff)
#define PROBE_STAMP(k) do { if (PROBE_ON && blockIdx.x == 0 && threadIdx.x == 0) { volatile LAS unsigned* pm_ = (volatile LAS unsigned*)(lds + MISC_OFF) + 16; const unsigned now_ = (unsigned)__builtin_amdgcn_s_memrealtime(); \
        if ((k) == PROBE_PH) pm_[1] = now_ - pm_[0]; if (PROBE_PH != 255) pm_[0] = now_; else if ((k) == NPH - 1) pm_[1] = now_ - pm_[0]; } } while (0)
constexpr int NPH = 18;

constexpr size_t MiB = 1u << 20;
constexpr size_t WS_CTL = 0, CTL_ZERO_BYTES = 49152;
constexpr size_t WS_MODS = 1 * MiB;
constexpr size_t WS_ROPE = WS_MODS + 512 * 1024;
constexpr size_t WS_WQA = 2 * MiB, WS_WOA = 5 * MiB, WS_WQB = 7 * MiB, WS_WOB = 10 * MiB;
constexpr size_t WS_W1 = 16 * MiB;
constexpr size_t WS_W2 = 272 * MiB;
constexpr size_t WS_H8 = 336 * MiB;
constexpr float WSCALE = 32.0f;
constexpr size_t WS_H = 400 * MiB;
constexpr size_t WS_QKV = 436 * MiB;
constexpr size_t WS_AO = 490 * MiB;
constexpr size_t WS_AP = 526 * MiB;
constexpr size_t WS_XB = 562 * MiB;
constexpr size_t WS_RT = 634 * MiB;
constexpr size_t RT_STRIDE = (size_t)T * 4 * 4;
constexpr size_t WS_LIST = 635 * MiB;
constexpr size_t WS_ACT = 638 * MiB;
constexpr size_t WS_Y = 798 * MiB;
constexpr size_t WS_END = 958 * MiB;
static_assert(WS_ROPE + 6400 * 4 <= WS_WQA && WS_WOB + 2 * MiB <= WS_W1 && WS_LIST + (size_t)NE * CAP * 4 <= WS_ACT && WS_RT + 3 * RT_STRIDE <= WS_LIST, "d_ws map");
static_assert((8192 + 64 * 64) * 4 <= (int)CTL_ZERO_BYTES && (4096 + 3456) * 4 <= 8192 * 4, "control words inside the memset region");
constexpr int CW_BAR = 4096;
constexpr int CW_CNT = 8192;

constexpr int RING_BYTES = 131072;
constexpr int MISC_OFF = RING_BYTES;
constexpr int TAB_OFF = RING_BYTES + 256;
constexpr int RSCR_OFF = RING_BYTES + 1024;
constexpr int LDS_BYTES = 147456;

#define LDS_WAIT() asm volatile("s_waitcnt lgkmcnt(0)" ::: "memory")
#define VM_WAIT() asm volatile("s_waitcnt vmcnt(0)" ::: "memory")
__device__ __forceinline__ unsigned f2bf(float f) { unsigned u = __builtin_bit_cast(unsigned, f); return (u + 0x7fffu + ((u >> 16) & 1u)) >> 16; }
__device__ __forceinline__ unsigned pk2(float lo, float hi) { return f2bf(lo) | (f2bf(hi) << 16); }
__device__ __forceinline__ float bflo(unsigned w) { return __builtin_bit_cast(float, w << 16); }
__device__ __forceinline__ float bfhi(unsigned w) { return __builtin_bit_cast(float, w & 0xffff0000u); }

#ifndef EARLY_INV
#define EARLY_INV 2
#endif
#ifndef FLAT_BAR
#define FLAT_BAR 0
#endif
#define XB_TMO      128
#define XB_XCNT(j)  (256  + 64 * (j))
#define XB_XSUB(j)  (1280 + 64 * (j))
#define XB_XGEN(j)  (2304 + 64 * (j))
#define XB_TOP      3328
#define XB_TOPGEN   3392
#define XCD_BAR_WORDS 3456
#define XB_SPIN_CAP (1u << 18)

__device__ __forceinline__ unsigned xb_ld(unsigned* p)              { return __hip_atomic_load(p, __ATOMIC_RELAXED, __HIP_MEMORY_SCOPE_AGENT); }
__device__ __forceinline__ unsigned xb_add(unsigned* p, unsigned v) { return __hip_atomic_fetch_add(p, v, __ATOMIC_RELAXED, __HIP_MEMORY_SCOPE_AGENT); }
__device__ __forceinline__ unsigned xb_xcc_id() { return (unsigned)__builtin_amdgcn_s_getreg((3 << 11) | 20) & 0xFu; }
#define XB_SPIN(cond, bar) do { unsigned _sp = 0; while (cond) { __builtin_amdgcn_s_sleep(1); \
    if ((++_sp & 255u) == 0u) { if (xb_ld(&(bar)[XB_TMO])) break; if (_sp > XB_SPIN_CAP) { atomicAdd(&(bar)[XB_TMO], 1u); break; } } } } while (0)

struct XcdBarrier {
    unsigned* bar; unsigned x;
    volatile LAS unsigned* st;
};

__device__ __forceinline__ XcdBarrier xcd_barrier_post(unsigned* bar, volatile LAS unsigned* st) {
    XcdBarrier b; b.bar = bar; b.x = xb_xcc_id(); b.st = st;
    if (!FLAT_BAR && threadIdx.x == 0) (void)xb_add(&bar[XB_XCNT(b.x)], 1u);
    return b;
}
__device__ __forceinline__ void xcd_barrier_complete(unsigned* bar, unsigned x, unsigned& nloc, unsigned& nx) {
    const unsigned G = gridDim.x * gridDim.y * gridDim.z;
    unsigned sum, cnt, mine, sp = 0u;
    for (;;) {
        sum = 0u; cnt = 0u; mine = 0u;
#pragma unroll
        for (unsigned j = 0; j < 16; ++j) { const unsigned c = xb_ld(&bar[XB_XCNT(j)]); sum += c; cnt += (c > 0u) ? 1u : 0u; mine = (j == x) ? c : mine; }
        if (sum == G) break;
        __builtin_amdgcn_s_sleep(1);
        if ((++sp & 255u) == 0u) { if (xb_ld(&bar[XB_TMO])) break; if (sp > XB_SPIN_CAP) { atomicAdd(&bar[XB_TMO], 1u); break; } }
    }
    nloc = mine > 0u ? mine : 1u; nx = cnt > 0u ? cnt : 1u;
}

__device__ __forceinline__ void flat_barrier(const XcdBarrier& b) {
    asm volatile("s_waitcnt vmcnt(0)" ::: "memory");
    __syncthreads();
    if (threadIdx.x < 64) {
        unsigned* bar = b.bar; const unsigned G = gridDim.x * gridDim.y * gridDim.z, ln = threadIdx.x;
        __builtin_amdgcn_s_waitcnt(0);
        __builtin_amdgcn_fence(__ATOMIC_RELEASE, "agent");
        asm volatile("s_waitcnt vmcnt(0)" ::: "memory");
        const unsigned round = b.st[0] + 1u;
        asm volatile("s_waitcnt lgkmcnt(0)" ::: "memory");
        if (ln == 0) { b.st[0] = round; (void)xb_add(&bar[XB_XSUB(b.x)], 1u); }
        const unsigned target = G * round; unsigned sp = 0u;
        for (;;) {
            unsigned c = ln < 16 ? xb_ld(&bar[XB_XSUB(ln)]) : 0u;
#pragma unroll
            for (int o = 1; o < 16; o <<= 1) c += __shfl_xor(c, o);
            c = __shfl(c, 0);
            if (c >= target) break;
            __builtin_amdgcn_s_sleep(1);
            if ((++sp & 255u) == 0u) { if (xb_ld(&bar[XB_TMO])) break; if (sp > XB_SPIN_CAP) { if (ln == 0) atomicAdd(&bar[XB_TMO], 1u); break; } }
        }
        __builtin_amdgcn_fence(__ATOMIC_ACQUIRE, "agent");
        asm volatile("s_waitcnt vmcnt(0)" ::: "memory");
    }
    __syncthreads();
}
__device__ __forceinline__ void xcd_barrier(const XcdBarrier& b) {
    if (FLAT_BAR) { flat_barrier(b); return; }
    asm volatile("s_waitcnt vmcnt(0)" ::: "memory");
    __syncthreads();
    if (threadIdx.x == 0) {
        unsigned* bar = b.bar;
        __builtin_amdgcn_s_waitcnt(0);
        if (EARLY_INV == 2) asm volatile("buffer_inv sc1" ::: "memory");
        unsigned nloc = b.st[0], nx = b.st[1];
        if (nloc == 0u) { xcd_barrier_complete(bar, b.x, nloc, nx); b.st[0] = nloc; b.st[1] = nx; }
        const unsigned old = xb_add(&bar[XB_XSUB(b.x)], 1u);
        const unsigned gen = old / nloc;
        if (old + 1u == (gen + 1u) * nloc) {
            __builtin_amdgcn_fence(__ATOMIC_RELEASE, "agent");
            asm volatile("s_waitcnt vmcnt(0)" ::: "memory");
            (void)xb_add(&bar[XB_TOP], 1u);
        }
        if (EARLY_INV == 1) asm volatile("buffer_inv sc1" ::: "memory");
        XB_SPIN(xb_ld(&bar[XB_TOP]) < nx * (gen + 1u), bar);
        if (!EARLY_INV) __builtin_amdgcn_fence(__ATOMIC_ACQUIRE, "agent");
        asm volatile("s_waitcnt vmcnt(0)" ::: "memory");
    }
    __syncthreads();
}

struct Args { const float* in[NIN]; float* out; unsigned char* ws; int ph_lo, ph_hi; };

__device__ __forceinline__ float wave_sum(float v) {
#pragma unroll
    for (int o = 1; o < 64; o <<= 1) v += __shfl_xor(v, o);
    return v;
}
struct Row { f32x4 v[4]; };
__device__ __forceinline__ Row ld_row_f32(const float* p, int lane) { Row r; const f32x4* q = (const f32x4*)p + lane;
#pragma unroll
    for (int j = 0; j < 4; ++j) r.v[j] = q[64 * j];
    return r; }
__device__ __forceinline__ Row ld_row_f32_nt(const float* p, int lane) { Row r; const f32x4* q = (const f32x4*)p + lane;
#pragma unroll
    for (int j = 0; j < 4; ++j) r.v[j] = __builtin_nontemporal_load(q + 64 * j);
    return r; }
__device__ __forceinline__ void st_row_f32_nt(float* p, int lane, const Row& r) { f32x4* q = (f32x4*)p + lane;
#pragma unroll
    for (int j = 0; j < 4; ++j) __builtin_nontemporal_store(r.v[j], q + 64 * j); }
__device__ __forceinline__ Row ld_row_bf16(const bf16* p, int lane) { Row r; const u32x2* q = (const u32x2*)p + lane;
#pragma unroll
    for (int j = 0; j < 4; ++j) { const u32x2 w = q[64 * j]; r.v[j] = (f32x4){bflo(w.x), bfhi(w.x), bflo(w.y), bfhi(w.y)}; }
    return r; }
__device__ __forceinline__ Row ld_row_fp8(const unsigned char* p, int lane) { Row r; const unsigned* q = (const unsigned*)p + lane;
#pragma unroll
    for (int j = 0; j < 4; ++j) { const int w = (int)q[64 * j]; const auto lo = __builtin_amdgcn_cvt_pk_f32_fp8(w, false), hi = __builtin_amdgcn_cvt_pk_f32_fp8(w, true); r.v[j] = (f32x4){lo[0], lo[1], hi[0], hi[1]}; }
    return r; }
struct RawBf { u32x2 v[4]; };
struct RawF8 { unsigned v[4]; };
__device__ __forceinline__ RawBf ld_raw_bf16_nt(const bf16* p, int lane) { RawBf r; const u32x2* q = (const u32x2*)p + lane;
#pragma unroll
    for (int j = 0; j < 4; ++j) r.v[j] = __builtin_nontemporal_load(q + 64 * j);
    return r; }
__device__ __forceinline__ RawBf ld_raw_bf16(const bf16* p, int lane) { RawBf r; const u32x2* q = (const u32x2*)p + lane;
#pragma unroll
    for (int j = 0; j < 4; ++j) r.v[j] = q[64 * j];
    return r; }
__device__ __forceinline__ RawF8 ld_raw_fp8(const unsigned char* p, int lane) { RawF8 r; const unsigned* q = (const unsigned*)p + lane;
#pragma unroll
    for (int j = 0; j < 4; ++j) r.v[j] = q[64 * j];
    return r; }
__device__ __forceinline__ Row cvt_raw(const RawBf& w) { Row r;
#pragma unroll
    for (int j = 0; j < 4; ++j) r.v[j] = (f32x4){bflo(w.v[j].x), bfhi(w.v[j].x), bflo(w.v[j].y), bfhi(w.v[j].y)};
    return r; }
__device__ __forceinline__ Row cvt_raw(const RawF8& w) { Row r;
#pragma unroll
    for (int j = 0; j < 4; ++j) { const auto lo = __builtin_amdgcn_cvt_pk_f32_fp8((int)w.v[j], false), hi = __builtin_amdgcn_cvt_pk_f32_fp8((int)w.v[j], true); r.v[j] = (f32x4){lo[0], lo[1], hi[0], hi[1]}; }
    return r; }
__device__ __forceinline__ void st_row_f32(float* p, int lane, const Row& r) { f32x4* q = (f32x4*)p + lane;
#pragma unroll
    for (int j = 0; j < 4; ++j) q[64 * j] = r.v[j]; }
__device__ __forceinline__ void st_row_bf16(bf16* p, int lane, const Row& r) { u32x2* q = (u32x2*)p + lane;
#pragma unroll
    for (int j = 0; j < 4; ++j) { u32x2 w; w.x = pk2(r.v[j].x, r.v[j].y); w.y = pk2(r.v[j].z, r.v[j].w); q[64 * j] = w; } }
__device__ __forceinline__ float row_rs(const Row& r) {
    float s = 0.f;
#pragma unroll
    for (int j = 0; j < 4; ++j) s += (r.v[j].x * r.v[j].x + r.v[j].y * r.v[j].y) + (r.v[j].z * r.v[j].z + r.v[j].w * r.v[j].w);
    return 1.0f / sqrtf(wave_sum(s) * (1.0f / DM) + EPS);
}
__device__ __forceinline__ Row norm_mod(const Row& x, float rs, const float* g, const float* sh, const float* sc, int lane) {
    const Row G = ld_row_f32(g, lane), SH = ld_row_f32(sh, lane), SC = ld_row_f32(sc, lane); Row h;
#pragma unroll
    for (int j = 0; j < 4; ++j) h.v[j] = (x.v[j] * rs * G.v[j]) * (SC.v[j] + 1.0f) + SH.v[j];
    return h;
}
__device__ __forceinline__ const float* src_row(const Args& a, int row) { const int b = row / RPB, t = row % RPB;
    return t < SEQ ? a.in[0] + ((size_t)b * SEQ + t) * DM : a.in[2] + ((size_t)b * CTXL + (t - SEQ)) * DM; }

template <int MODE>
__device__ __forceinline__ void transpose_item(const float* W, int K, int N, bf16* WT, LAS float* scr, int item, int lane) {
    const int nblk = N / 32, kb = item / nblk, nb = item % nblk, k0 = 64 * kb, n0 = 32 * nb;
#pragma unroll 8
    for (int i = 0; i < 32; ++i) { const int kk = 2 * i + (lane >> 5); scr[kk * 33 + (lane & 31)] = __builtin_nontemporal_load(W + (size_t)(k0 + kk) * N + n0 + (lane & 31)); }
    LDS_WAIT(); asm volatile("" ::: "memory");
    const int c = lane & 7;
#pragma unroll
    for (int j = 0; j < 4; ++j) { const int n = (lane >> 3) + 8 * j; const LAS float* s = scr + (8 * c) * 33 + n;
        u32x4 o; o.x = pk2(s[0 * 33], s[1 * 33]); o.y = pk2(s[2 * 33], s[3 * 33]); o.z = pk2(s[4 * 33], s[5 * 33]); o.w = pk2(s[6 * 33], s[7 * 33]);
        int nn = n0 + n;
        if (MODE == 2 && nn < 1152) { const int d = nn & 63, reg = d >> 4, i = d & 15; nn = (nn & ~63) + (((reg >> 1) * 4 + (i >> 2)) * 8) + ((reg & 1) * 4 + (i & 3)); }
        if (MODE == 3 && nn < 1280) { const int d = nn & 127, reg = d >> 5, i = d & 31; nn = (nn & ~127) + (((reg >> 1) * 8 + (i >> 2)) * 8) + ((reg & 1) * 4 + (i & 3)); }
        *(u32x4*)(WT + (size_t)nn * K + k0 + 8 * c) = o; }
    LDS_WAIT(); asm volatile("" ::: "memory");
}
__device__ __forceinline__ unsigned pack4_fp8(float a, float b, float c, float d) { int w = 0; w = __builtin_amdgcn_cvt_pk_fp8_f32(a, b, w, false); w = __builtin_amdgcn_cvt_pk_fp8_f32(c, d, w, true); return (unsigned)w; }
template <int MODE, bool NTST = true>
__device__ __forceinline__ void transpose_item_f8_fin(const float (&tv)[64], int K, int N, unsigned char* WT, LAS float* scr, int item, int lane) {
    const int nblk = N / 32, kb = item / nblk, nb = item % nblk, k0 = 128 * kb, n0 = 32 * nb;
    const int c = lane & 3;
    u32x4 o[2][2];
#pragma unroll
    for (int h = 0; h < 2; ++h) {
#pragma unroll
        for (int i = 0; i < 32; ++i) { const int kk = 2 * i + (lane >> 5); scr[kk * 33 + (lane & 31)] = tv[32 * h + i] * WSCALE; }
        LDS_WAIT(); asm volatile("" ::: "memory");
#pragma unroll
        for (int j = 0; j < 2; ++j) { const int n = (lane >> 2) + 16 * j; const LAS float* s = scr + (16 * c) * 33 + n;
            o[h][j].x = pack4_fp8(s[0 * 33], s[1 * 33], s[2 * 33], s[3 * 33]); o[h][j].y = pack4_fp8(s[4 * 33], s[5 * 33], s[6 * 33], s[7 * 33]);
            o[h][j].z = pack4_fp8(s[8 * 33], s[9 * 33], s[10 * 33], s[11 * 33]); o[h][j].w = pack4_fp8(s[12 * 33], s[13 * 33], s[14 * 33], s[15 * 33]); }
        LDS_WAIT(); asm volatile("" ::: "memory");
    }
#pragma unroll
    for (int j = 0; j < 2; ++j) { int nn = n0 + (lane >> 2) + 16 * j;
        if (MODE == 1) nn = (nn < 1024) ? ((nn >> 7) * 256 + (nn & 127)) : ((((nn - 1024) >> 7) * 256) + 128 + (nn & 127));
        unsigned char* rowp = WT + (size_t)nn * K + k0 + 16 * c;
        if constexpr (NTST) { __builtin_nontemporal_store(o[0][j], (u32x4*)rowp); __builtin_nontemporal_store(o[1][j], (u32x4*)(rowp + 64)); }
        else { *(u32x4*)rowp = o[0][j]; *(u32x4*)(rowp + 64) = o[1][j]; } }
}
__device__ __forceinline__ void transpose_item_f8_ld(float (&tv)[64], const float* W, int N, int item, int lane) {
    const int nblk = N / 32, kb = item / nblk, nb = item % nblk, k0 = 128 * kb, n0 = 32 * nb;
#pragma unroll
    for (int i = 0; i < 64; ++i) { const int kk = 2 * i + (lane >> 5); tv[i] = __builtin_nontemporal_load(W + (size_t)(k0 + kk) * N + n0 + (lane & 31)); }
}
template <int MODE, bool NTST = true>
__device__ __forceinline__ void transpose_item_f8(const float* W, int K, int N, unsigned char* WT, LAS float* scr, int item, int lane) {
    float tv[64]; transpose_item_f8_ld(tv, W, N, item, lane); transpose_item_f8_fin<MODE, NTST>(tv, K, N, WT, scr, item, lane);
}
__device__ __forceinline__ void mods_item(const float* w_ada, const float* b_ada, float* mods, const LAS float* S, int it, int lane) {
    const int l = it / 384, cc = it % 384, kq = lane >> 4, col = cc * 16 + (lane & 15);
    const float* W = w_ada + (size_t)l * DM * 6144 + col;
    float acc[9];
#pragma unroll
    for (int r = 0; r < 9; ++r) acc[r] = 0.f;
#pragma unroll 8
    for (int kk = 0; kk < 256; ++kk) { const int k = kk * 4 + kq; const float w = __builtin_nontemporal_load(W + (size_t)k * 6144);
#pragma unroll
        for (int r = 0; r < 9; ++r) acc[r] += S[r * 1024 + k] * w; }
#pragma unroll
    for (int r = 0; r < 9; ++r) { acc[r] += __shfl_xor(acc[r], 16); acc[r] += __shfl_xor(acc[r], 32); }
    if (lane < 16) { const float bb = b_ada[l * 6144 + col];
#pragma unroll
        for (int r = 0; r < 9; ++r) mods[((size_t)l * 9 + r) * 6144 + col] = acc[r] + bb; }
}
constexpr int I_MOD = 2 * 384, I_QA = 16 * (NQA / 32), I_O = 16 * 32, I_QB = 16 * (NQB / 32), I_W1 = 64 * 512, I_W2 = 64 * 256;
constexpr int N_ITEMS0 = I_MOD + I_QA + I_O + I_QB + I_O;
#ifndef W1_LATE
#define W1_LATE 0
#endif
#ifndef CONV_A
#define CONV_A 0
#endif
#ifndef CONV_B
#define CONV_B 0
#endif
#define CONV_CNT(l) ((l) == 0 ? CONV_A : CONV_B)
#ifndef BGW
#define BGW 0
#endif
#ifndef WQ2
#define WQ2 4400
#endif
#ifndef WQ4
#define WQ4 9000
#endif
#ifndef WQ5
#define WQ5 2984
#endif
#ifndef CONV_MOD_A
#define CONV_MOD_A 5
#endif
#ifndef TOKB_MIX
#define TOKB_MIX 1
#endif
#ifndef QKB_FUSE
#define QKB_FUSE 1
#endif
#ifndef MODS_SPLIT
#define MODS_SPLIT 1
#endif
#ifndef TOKB_RPI
#define TOKB_RPI 3
#endif
#ifndef EARLY_A
#define EARLY_A 3
#endif
#ifndef EARLY_B
#define EARLY_B 6
#endif
#ifndef W1_FIRST
#define W1_FIRST 0
#endif
#ifndef MODS_WORTH
#define MODS_WORTH 10
#endif

__device__ __forceinline__ void phase_pro_a(const Args& a, unsigned char* ws, LAS unsigned char* lds, int tid, int lane, int wave, int vcu, int G) {
    LAS float* S = (LAS float*)(lds + 69632);
    for (int i = tid; i < 9 * 1024; i += 512) { const float v = i < 8192 ? a.in[1][i] : a.in[3][i - 8192]; S[i] = v / (1.0f + expf(-v)); }
    __syncthreads();
    LAS float* scr = (LAS float*)(lds + wave * 8448);
    const int gw = vcu * 8 + wave, NGW = G * 8;
    if (MODS_SPLIT) {
        LAS float* part = (LAS float*)(lds + 106496);
        for (int it = vcu; it < I_MOD; it += G) {
            const int l = it / 384, cc = it % 384, kq = lane >> 4, col = cc * 16 + (lane & 15);
            const float* W = a.in[4] + (size_t)l * DM * 6144 + col;
            float w[32];
#pragma unroll
            for (int kk = 0; kk < 32; ++kk) w[kk] = __builtin_nontemporal_load(W + (size_t)(wave * 128 + kk * 4 + kq) * 6144);
            float acc[9];
#pragma unroll
            for (int r = 0; r < 9; ++r) acc[r] = 0.f;
#pragma unroll
            for (int kk = 0; kk < 32; ++kk) { const int k = wave * 128 + kk * 4 + kq;
#pragma unroll
                for (int r = 0; r < 9; ++r) acc[r] += S[r * 1024 + k] * w[kk]; }
#pragma unroll
            for (int r = 0; r < 9; ++r) { acc[r] += __shfl_xor(acc[r], 16); acc[r] += __shfl_xor(acc[r], 32); }
            if (lane < 16) {
#pragma unroll
                for (int r = 0; r < 9; ++r) part[(wave * 9 + r) * 16 + lane] = acc[r]; }
            __syncthreads();
            if (tid < 144) { const int r = tid >> 4, c = tid & 15; float v = a.in[5][l * 6144 + cc * 16 + c];
#pragma unroll
                for (int w8 = 0; w8 < 8; ++w8) v += part[(w8 * 9 + r) * 16 + c];
                ((float*)(ws + WS_MODS))[((size_t)l * 9 + r) * 6144 + cc * 16 + c] = v; }
            __syncthreads();
        }
        for (int it = gw; it < N_ITEMS0 - I_MOD; it += NGW) {
            int r = it;
            if (r < I_QA) { transpose_item<2>(a.in[7], DM, NQA, (bf16*)(ws + WS_WQA), scr, r, lane); continue; } r -= I_QA;
            if (r < I_O) { transpose_item<0>(a.in[8], DM, DM, (bf16*)(ws + WS_WOA), scr, r, lane); continue; } r -= I_O;
            if (r < I_QB) { transpose_item<(QKB_FUSE ? 3 : 0)>(a.in[10], DM, NQB, (bf16*)(ws + WS_WQB), scr, r, lane); continue; } r -= I_QB;
            transpose_item<0>(a.in[13], DM, DM, (bf16*)(ws + WS_WOB), scr, r, lane);
        }
    } else
    for (int it = gw; it < N_ITEMS0; it += NGW) {
        int r = it;
        if (r < I_MOD) { mods_item(a.in[4], a.in[5], (float*)(ws + WS_MODS), S, r, lane); continue; } r -= I_MOD;
        if (r < I_QA) { transpose_item<2>(a.in[7], DM, NQA, (bf16*)(ws + WS_WQA), scr, r, lane); continue; } r -= I_QA;
        if (r < I_O) { transpose_item<0>(a.in[8], DM, DM, (bf16*)(ws + WS_WOA), scr, r, lane); continue; } r -= I_O;
        if (r < I_QB) { transpose_item<(QKB_FUSE ? 3 : 0)>(a.in[10], DM, NQB, (bf16*)(ws + WS_WQB), scr, r, lane); continue; } r -= I_QB;
        transpose_item<0>(a.in[13], DM, DM, (bf16*)(ws + WS_WOB), scr, r, lane);
    }
    if (!W1_LATE) { constexpr int NC = I_W1 + I_W2; const int nfree = NGW > I_MOD ? NGW - I_MOD : 0, A = nfree ? NC - (MODS_WORTH * nfree < NC ? MODS_WORTH * nfree : NC) : NC;
#define MOE_ITEM(r_) do { const int r__ = (r_); if (r__ < I_W1) { const int m = r__ >> 9; transpose_item_f8<1>(a.in[16] + (size_t)m * DM * 2048, DM, 2048, ws + WS_W1 + (size_t)m * 2048 * DM, scr, r__ & 511, lane); } \
        else { const int q__ = r__ - I_W1, m = q__ >> 8; transpose_item_f8<0>(a.in[18] + (size_t)m * DM * DM, DM, DM, ws + WS_W2 + (size_t)m * DM * DM, scr, q__ & 255, lane); } } while (0)
      for (int it = gw; it < A; it += NGW) MOE_ITEM(it);
      if (gw >= I_MOD) for (int it = A + gw - I_MOD; it < NC; it += nfree) MOE_ITEM(it);
#undef MOE_ITEM
    }
    if (vcu == 0) {
        float* rp = (float*)(ws + WS_ROPE);
        for (int i = tid; i < 1024; i += 512) { const int pos = i >> 4, f = i & 15; const float inv = exp2f(-(float)f * (13.287712379549449f / 16.0f)); const float ang = (float)pos * inv;
            rp[i] = cosf(ang); rp[1024 + i] = sinf(ang); }
        for (int i = tid; i < 2048; i += 512) { const int pos = i >> 5, f = i & 31; const float inv = exp2f(-(float)f * (13.287712379549449f / 32.0f)); const float ang = (float)pos * inv;
            rp[2048 + i] = cosf(ang); rp[4096 + i] = sinf(ang); }
        if (tid < 128) rp[6144 + tid] = a.in[11][tid];
    }
}
__device__ __forceinline__ void phase_pro_b(const Args& a, unsigned char* ws, int lane, int gw, int NGW) {
    const float* mods = (const float*)(ws + WS_MODS); bf16* H = (bf16*)(ws + WS_H);
    if (gw >= T) return;
    Row nx = ld_row_f32(src_row(a, gw), lane);
    for (int row = gw; row < T; row += NGW) {
        const Row x = nx; const int nrow = row + NGW < T ? row + NGW : row; nx = ld_row_f32(src_row(a, nrow), lane);
        const int b = row / RPB, t = row % RPB; const float* mod = mods + (size_t)(t < SEQ ? b : 8) * 6144;
        const Row h = norm_mod(x, row_rs(x), a.in[6], mod, mod + 1024, lane);
        st_row_bf16(H + (size_t)row * DM, lane, h);
    }
}
__device__ __forceinline__ void phase_qkfix_b(const Args& a, unsigned char* ws, int gtid, int NGT) {
    bf16* QKV = (bf16*)(ws + WS_QKV); const float* rc = (const float*)(ws + WS_ROPE) + 2048; const float* rs = rc + 2048;
    for (int f = gtid; f < T * 80; f += NGT) {
        const int sub = f & 7, hd = (f >> 3) % 10, row = f / 80, t = row % RPB; const bool lat = t < SEQ;
        if (!lat && hd < 8) continue;
        const int half = sub >> 2, c = (sub & 3) + half * 8, pos = half ? (t & 63) : (t >> 6), f0 = (sub & 3) * 8;
        bf16* p1 = QKV + (size_t)row * NQB + hd * 128 + c * 8; bf16* p2 = p1 + 32;
        const u32x4 A = *(const u32x4*)p1, Bv = *(const u32x4*)p2; u32x4 OA, OB;
        float ss = 0.f;
#pragma unroll
        for (int i = 0; i < 4; ++i) { const float x10 = bflo(A[i]), x11 = bfhi(A[i]), x20 = bflo(Bv[i]), x21 = bfhi(Bv[i]); ss += (x10 * x10 + x11 * x11) + (x20 * x20 + x21 * x21); }
        ss += __shfl_xor(ss, 1); ss += __shfl_xor(ss, 2); ss += __shfl_xor(ss, 4);
        const float rn = 1.0f / sqrtf(ss * (1.0f / 128.0f) + EPS);
        const float* gn = (hd < 8 ? a.in[11] : a.in[12]);
#pragma unroll
        for (int i = 0; i < 4; ++i) {
            const int e1 = c * 8 + 2 * i, e2 = e1 + 32;
            const float y10 = bflo(A[i]) * rn * gn[e1], y11 = bfhi(A[i]) * rn * gn[e1 + 1], y20 = bflo(Bv[i]) * rn * gn[e2], y21 = bfhi(Bv[i]) * rn * gn[e2 + 1];
            if (lat) {
                const float cs0 = rc[pos * 32 + f0 + 2 * i], sn0 = rs[pos * 32 + f0 + 2 * i], cs1 = rc[pos * 32 + f0 + 2 * i + 1], sn1 = rs[pos * 32 + f0 + 2 * i + 1];
                OA[i] = pk2(y10 * cs0 - y20 * sn0, y11 * cs1 - y21 * sn1); OB[i] = pk2(y20 * cs0 + y10 * sn0, y21 * cs1 + y11 * sn1);
            } else { OA[i] = pk2(y10, y11); OB[i] = pk2(y20, y21); } }
        *(u32x4*)p1 = OA; *(u32x4*)p2 = OB;
    }
}
__device__ __forceinline__ att::Conv conv_ctx(const Args& a, unsigned char* ws, int l, int cnt, int vcu, int G) {
    const int wave = __builtin_amdgcn_readfirstlane((int)threadIdx.x >> 6), gw = vcu * 8 + wave, NGW = G * 8;
    att::Conv c; c.w1 = a.in[16] + (size_t)l * NE * DM * 2048; c.w2 = a.in[18] + (size_t)l * NE * DM * DM; c.o1 = ws + WS_W1 + (size_t)l * NE * 2048 * DM; c.o2 = ws + WS_W2 + (size_t)l * NE * DM * DM;
    c.next = gw; c.end = cnt * NGW < 49152 ? cnt * NGW : 49152; c.stride = NGW; c.pend = -1; c.scr = wave < 7 ? 67584 + wave * 8192 : 135168; c.tick = wave;
    return c;
}
__device__ __forceinline__ void phase_attn_a(const Args& a, unsigned char* ws, char* lds, int vcu, int G) {
    const bf16* QKV = (const bf16*)(ws + WS_QKV); bf16* AO = (bf16*)(ws + WS_AO);
    att::Conv cv = conv_ctx(a, ws, 0, CONV_A, vcu, G); LAS unsigned char* ldsl = (LAS unsigned char*)lds; const int lane_ = threadIdx.x & 63;
    constexpr int NU = NB * 16 * 8 + NB * 16;
    for (int u = vcu; u < NB * 128; u += G) {
        __syncthreads();
        const int b = u >> 7, h = (u >> 3) & 15, qb = u & 7, g = h >> 3, q0 = qb * 256;
        const int ws0 = q0 >= 128 ? q0 - 128 : 0, we = q0 + 384 < SEQ ? q0 + 384 : SEQ, nwin = (we - ws0) >> 6;
        const bf16* base = QKV + (size_t)b * RPB * NQA;
        att::attn_unit<64, true, NQA, false, (CONV_A > 0), CONV_MOD_A, 1>(base + (size_t)q0 * NQA + h * 64, base + 1024 + g * 64, base + 1152 + g * 64, AO + ((size_t)b * RPB + q0) * DM + h * 64,
                                      nwin, ws0, SEQ, nwin + 4, q0, a.in[9][h] * 8.0f, 1.0f, lds, nullptr, &cv, ldsl);
    }
    const bool bal = (G == 256); const int qr_ = vcu & 7, nctx = bal ? ((qr_ == 0 || qr_ == 7) ? 2 : 0) : 0, j0 = ((vcu >> 3) * 2 + (qr_ == 7 ? 1 : 0)) * 2;
    for (int c = 0; bal ? (c < nctx) : (NB * 128 + vcu + c * G < NU); ++c) {
        __syncthreads();
        const int v = bal ? j0 + c : vcu + c * G, b = v >> 4, h = v & 15, g = h >> 3;
        const bf16* base = QKV + (size_t)b * RPB * NQA;
        att::attn_unit<64, false, NQA>(base + (size_t)SEQ * NQA + h * 64, base + 1024 + g * 64, base + 1152 + g * 64, AO + ((size_t)b * RPB + SEQ) * DM + h * 64,
                                       0, 0, SEQ, 4, 0, a.in[9][h] * 8.0f, 1.0f, lds);
    }
    if (CONV_A > 0) { __syncthreads(); att::conv_drain(cv, ldsl, lane_); }
}
__device__ __forceinline__ void phase_attn_b(const Args& a, unsigned char* ws, char* lds, int vcu, int G) {
    const bf16* QKV = (const bf16*)(ws + WS_QKV); bf16* AO = (bf16*)(ws + WS_AO);
    constexpr int NU = NB * 8 * 8;
    att::Conv cv = conv_ctx(a, ws, 1, CONV_B, vcu, G); LAS unsigned char* ldsl = (LAS unsigned char*)lds; const int lane_ = threadIdx.x & 63;
    for (int u = vcu; u < NU; u += G) {
        __syncthreads();
        const int b = u >> 6, h = (u >> 3) & 7, qb = u & 7, g = h >> 2, q0 = qb * 256;
        const bf16* base = QKV + (size_t)b * RPB * NQB;
        att::attn_unit<128, false, NQB, false, (CONV_B > 0), CONV_MOD, CONV_ON>(base + (size_t)q0 * NQB + h * 128, base + 1024 + g * 128, base + 1280 + g * 128, AO + ((size_t)b * RPB + q0) * DM + h * 128,
                                        36, 0, 0, 36, q0, -1e30f, 0.0f, lds, nullptr, &cv, ldsl);
    }
    if (CONV_B > 0) { __syncthreads(); att::conv_drain(cv, ldsl, lane_); }
}
__device__ __forceinline__ void phase_tok_b(const Args& a, unsigned char* ws, LAS unsigned char* lds, int l, int tid, int lane, int wave, int gw, int NGW) {
    constexpr int SLOTS = 12;
    constexpr int RPI = TOKB_RPI, NTK = 8 * RPI;
    constexpr int ROWB = 2048 + 16, TILE_LO = NTK * ROWB, RED_OFF = 2 * NTK * ROWB;
    static_assert(SLOTS % RPI == 0 && NTK <= 32 && RED_OFF + 8 * NTK * 32 * 4 <= RING_BYTES, "token phase B LDS");
    LAS float* rsc_all = (LAS float*)(lds + RSCR_OFF); LAS float* rsc = rsc_all + wave * (SLOTS * 32);
    LAS int* bcnt = (LAS int*)(lds + RSCR_OFF + 8 * SLOTS * 32 * 4); LAS int* bbase = bcnt + 32;
    LAS float* red = (LAS float*)(lds + RED_OFF);
    const float* mods = (const float*)(ws + WS_MODS) + (size_t)l * 9 * 6144; const float* gn = a.in[6] + (size_t)l * 4 * DM;
    const bf16* AP = (const bf16*)(ws + WS_AP); bf16* XB = (bf16*)(ws + WS_XB); unsigned char* H8 = ws + WS_H8;
    int* cnt = (int*)(ws + WS_CTL) + CW_CNT + l * 32 * 64; int* list = (int*)(ws + WS_LIST);
    int* texp = (int*)(ws + WS_RT); int* tpos = (int*)(ws + WS_RT + RT_STRIDE); float* tgate = (float*)(ws + WS_RT + 2 * RT_STRIDE);
    const float* br = a.in[15] + l * NE;
    const int nrows = l == 0 ? T : NB * SEQ;
    bf16x8 Bh[8], Bl[8];
    { const float* wr = a.in[14] + (size_t)l * DM * NE + (size_t)(128 * wave + 8 * (lane >> 5)) * NE + (lane & 31);
#pragma unroll
      for (int s2 = 0; s2 < 8; ++s2) { u32x4 wh, wl;
#pragma unroll
        for (int jj = 0; jj < 4; ++jj) { const float w0 = wr[(size_t)(16 * s2 + 2 * jj) * NE], w1 = wr[(size_t)(16 * s2 + 2 * jj + 1) * NE];
            const unsigned ph = pk2(w0, w1); wh[jj] = ph; wl[jj] = pk2(w0 - bflo(ph), w1 - bfhi(ph)); }
        Bh[s2] = __builtin_bit_cast(bf16x8, wh); Bl[s2] = __builtin_bit_cast(bf16x8, wl); } }
#define TOKB_ROW(r0_) (l == 0 ? (r0_) : ((r0_) >> 11) * RPB + ((r0_) & 2047))
    const int per_wave = (nrows + NGW - 1) / NGW, nchunk = (per_wave + SLOTS - 1) / SLOTS;
    for (int ch = 0; ch < nchunk; ++ch) {
        const int rbeg = gw + ch * SLOTS * NGW;
        const int nsl = per_wave - ch * SLOTS < SLOTS ? per_wave - ch * SLOTS : SLOTS;
        const int nit = (nsl + RPI - 1) / RPI;
        if (tid < 32) bcnt[tid] = 0;
        int ns = 0;
        RawBf nav, nrb; Row nrf;
        { const int r0c = rbeg < nrows ? rbeg : gw; const int rowp = TOKB_ROW(r0c);
          nav = ld_raw_bf16_nt(AP + (size_t)rowp * DM, lane); nrb = nav; if (l == 0) nrf = ld_row_f32_nt(src_row(a, rowp), lane); else nrb = ld_raw_bf16_nt(XB + (size_t)rowp * DM, lane); }
        for (int it = 0; it < nit; ++it) {
#pragma unroll
          for (int j = 0; j < RPI; ++j) {
            const int s = it * RPI + j, r0 = rbeg + s * NGW; const bool valid = s < nsl && r0 < nrows;
            if (valid) {
                ns = s + 1;
                const int row = TOKB_ROW(r0);
                const int b = row / RPB, t = row % RPB; const float* mod = mods + (size_t)(t < SEQ ? b : 8) * 6144;
                const Row av = cvt_raw(nav); Row res; if (l == 0) res = nrf; else res = cvt_raw(nrb);
                { const int nr0 = (s + 1 < nsl && r0 + NGW < nrows) ? r0 + NGW : r0, nrow = TOKB_ROW(nr0);
                  nav = ld_raw_bf16_nt(AP + (size_t)nrow * DM, lane); if (l == 0) nrf = ld_row_f32_nt(src_row(a, nrow), lane); else nrb = ld_raw_bf16_nt(XB + (size_t)nrow * DM, lane); }
                const float rs1 = row_rs(av);
                const Row G1 = ld_row_f32(gn + DM, lane), GT = ld_row_f32(mod + 2048, lane); Row x1;
#pragma unroll
                for (int jj = 0; jj < 4; ++jj) x1.v[jj] = res.v[jj] + GT.v[jj] * (av.v[jj] * rs1 * G1.v[jj]);
                st_row_bf16(XB + (size_t)row * DM, lane, x1);
                const Row h2 = norm_mod(x1, row_rs(x1), gn + 2 * DM, mod + 3072, mod + 4096, lane);
                { unsigned* q8 = (unsigned*)(H8 + (size_t)row * DM) + lane;
#pragma unroll
                  for (int jj = 0; jj < 4; ++jj) q8[64 * jj] = pack4_fp8(h2.v[jj].x, h2.v[jj].y, h2.v[jj].z, h2.v[jj].w); }
#pragma unroll
                for (int jj = 0; jj < 4; ++jj) { const unsigned h0 = pk2(h2.v[jj].x, h2.v[jj].y), h1 = pk2(h2.v[jj].z, h2.v[jj].w);
                    const unsigned l0 = pk2(h2.v[jj].x - bflo(h0), h2.v[jj].y - bfhi(h0)), l1 = pk2(h2.v[jj].z - bflo(h1), h2.v[jj].w - bfhi(h1));
                    *(LAS u32x2*)(lds + (8 * j + wave) * ROWB + (4 * lane + 256 * jj) * 2) = (u32x2){h0, h1};
                    *(LAS u32x2*)(lds + TILE_LO + (8 * j + wave) * ROWB + (4 * lane + 256 * jj) * 2) = (u32x2){l0, l1}; }
            }
          }
            LDS_WAIT(); __syncthreads();
            { f32x16 acc = {};
              const int mrow = (lane & 31) < NTK ? (lane & 31) : (lane & 31) - 8;
              const LAS unsigned char* arow = lds + mrow * ROWB + (128 * wave + 8 * (lane >> 5)) * 2;
#pragma unroll
              for (int s2 = 0; s2 < 8; ++s2) { const bf16x8 ah = *(const LAS bf16x8*)(arow + 32 * s2), al = *(const LAS bf16x8*)(arow + TILE_LO + 32 * s2);
                  acc = __builtin_amdgcn_mfma_f32_32x32x16_bf16(ah, Bh[s2], acc, 0, 0, 0);
                  acc = __builtin_amdgcn_mfma_f32_32x32x16_bf16(ah, Bl[s2], acc, 0, 0, 0);
                  acc = __builtin_amdgcn_mfma_f32_32x32x16_bf16(al, Bh[s2], acc, 0, 0, 0); }
#pragma unroll
              for (int r = 0; r < 4 * RPI; ++r) red[(wave * NTK + 8 * (r >> 2) + 4 * (lane >> 5) + (r & 3)) * 32 + (lane & 31)] = acc[r]; }
            LDS_WAIT(); __syncthreads();
            for (int idx = tid; idx < NTK * 32; idx += 512) { const int pt = idx >> 5, e = idx & 31; float lg = br[e];
#pragma unroll
                for (int w = 0; w < 8; ++w) lg += red[(w * NTK + pt) * 32 + e];
                rsc_all[(pt & 7) * (SLOTS * 32) + (it * RPI + (pt >> 3)) * 32 + e] = lg; }
        }
        LDS_WAIT(); __syncthreads();
        int ti[4]; float tg[4]; int lr[4];
        if (lane < ns) {
            float v[32];
#pragma unroll
            for (int q = 0; q < 8; ++q) { const f32x4 w = *(const LAS f32x4*)(rsc + lane * 32 + 4 * q); v[4 * q] = w.x; v[4 * q + 1] = w.y; v[4 * q + 2] = w.z; v[4 * q + 3] = w.w; }
            unsigned taken = 0u; float tv[4];
#pragma unroll
            for (int k = 0; k < 4; ++k) { float best = -3.0e38f; int bi = 0;
#pragma unroll
                for (int e = 0; e < 32; ++e) { const bool ok = !((taken >> e) & 1u) && v[e] > best; best = ok ? v[e] : best; bi = ok ? e : bi; }
                taken |= 1u << bi; tv[k] = best; ti[k] = bi; }
            const float e1 = expf(tv[1] - tv[0]), e2 = expf(tv[2] - tv[0]), e3 = expf(tv[3] - tv[0]), inv = 1.0f / (1.0f + e1 + e2 + e3);
            tg[0] = inv; tg[1] = e1 * inv; tg[2] = e2 * inv; tg[3] = e3 * inv;
#pragma unroll
            for (int k = 0; k < 4; ++k) lr[k] = __hip_atomic_fetch_add(bcnt + ti[k], 1, __ATOMIC_RELAXED, __HIP_MEMORY_SCOPE_WORKGROUP);
        }
        LDS_WAIT(); __syncthreads();
        if (tid < 32) { const int n = bcnt[tid]; bbase[tid] = n ? atomicAdd(cnt + tid * 64, n) : 0; }
        LDS_WAIT(); __syncthreads();
        if (lane < ns) { const int row = TOKB_ROW(rbeg + lane * NGW);
#pragma unroll
            for (int k = 0; k < 4; ++k) { const int pos = bbase[ti[k]] + lr[k]; list[(size_t)ti[k] * CAP + pos] = row; texp[row * 4 + k] = ti[k]; tpos[row * 4 + k] = pos; tgate[row * 4 + k] = tg[k]; } }
        __syncthreads();
    }
#undef TOKB_ROW
}
__device__ __forceinline__ void conv_range(const Args& a, unsigned char* ws, LAS unsigned char* lds, int l, int which, int lo, int hi, int lane, int wave, int widx, int nw, bool deep = false) {
    __syncthreads(); LAS float* scr = (LAS float*)(lds + wave * 8448);
    if (deep && which == 0) {
        int it = lo + widx;
        for (; it + nw < hi; it += 2 * nw) { const int m0 = l * 32 + (it >> 9), m1 = l * 32 + ((it + nw) >> 9); float ta[64], tb[64];
            transpose_item_f8_ld(ta, a.in[16] + (size_t)m0 * DM * 2048, 2048, it & 511, lane); transpose_item_f8_ld(tb, a.in[16] + (size_t)m1 * DM * 2048, 2048, (it + nw) & 511, lane);
            transpose_item_f8_fin<1, false>(ta, DM, 2048, ws + WS_W1 + (size_t)m0 * 2048 * DM, scr, it & 511, lane);
            transpose_item_f8_fin<1, false>(tb, DM, 2048, ws + WS_W1 + (size_t)m1 * 2048 * DM, scr, (it + nw) & 511, lane); }
        if (it < hi) { const int m = l * 32 + (it >> 9); transpose_item_f8<1, false>(a.in[16] + (size_t)m * DM * 2048, DM, 2048, ws + WS_W1 + (size_t)m * 2048 * DM, scr, it & 511, lane); }
        __syncthreads(); return;
    }
    if (which == 0) for (int it = lo + widx; it < hi; it += nw) { const int m = l * 32 + (it >> 9); transpose_item_f8<1, false>(a.in[16] + (size_t)m * DM * 2048, DM, 2048, ws + WS_W1 + (size_t)m * 2048 * DM, scr, it & 511, lane); }
    else for (int it = lo + widx; it < hi; it += nw) { const int m = l * 32 + (it >> 8); transpose_item_f8<0, false>(a.in[18] + (size_t)m * DM * DM, DM, DM, ws + WS_W2 + (size_t)m * DM * DM, scr, it & 255, lane); }
    __syncthreads();
}
__device__ __forceinline__ int idle_index(int units, int G, int c, int& n_idle) { const int rounds = (units + G - 1) / G, last = units - (rounds - 1) * G; n_idle = G - last; return c >= last ? c - last : -1; }
__device__ __forceinline__ int early_items(int l, int G) { int ni; idle_index(l == 0 ? 288 : 432, G, 0, ni); const int x = ni * 8 * (l == 0 ? EARLY_A : EARLY_B); return x < 32 * 512 ? x : 32 * 512; }
__device__ __forceinline__ void moe_tables(unsigned char* ws, LAS unsigned char* lds, int l, int tid) {
    LAS int* tab = (LAS int*)(lds + TAB_OFF);
    __syncthreads();
    if (tid < 64) { const int* cnt = (const int*)(ws + WS_CTL) + CW_CNT + l * 32 * 64; const int e = tid & 31;
        const int n = __hip_atomic_load(cnt + e * 64, __ATOMIC_RELAXED, __HIP_MEMORY_SCOPE_AGENT); const int tl = (n + 255) >> 8; int incl = tl;
#pragma unroll
        for (int d = 1; d < 32; d <<= 1) { const int v = __shfl_up(incl, d, 32); if (e >= d) incl += v; }
        if (tid < 32) { tab[e] = n; tab[32 + e] = incl - tl; if (e == 31) { tab[64] = incl; tab[65] = incl; } } }
    __syncthreads();
}
__device__ __forceinline__ void phase_tok_c(const Args& a, unsigned char* ws, LAS unsigned char* lds, int l, int lane, int gw, int NGW) {
    const LAS int* tab = (const LAS int*)(lds + TAB_OFF);
    const float* mods = (const float*)(ws + WS_MODS); const float* gn = a.in[6] + (size_t)l * 4 * DM;
    const unsigned char* Y = ws + WS_Y; bf16* XB = (bf16*)(ws + WS_XB); bf16* H = (bf16*)(ws + WS_H);
    const i32x4* texp = (const i32x4*)(ws + WS_RT); const i32x4* tpos = (const i32x4*)(ws + WS_RT + RT_STRIDE); const f32x4* tgate = (const f32x4*)(ws + WS_RT + 2 * RT_STRIDE);
    const int nrows = l == 0 ? T : NB * SEQ;
    if (gw >= nrows) return;
#define TOKC_ROW(r0_) (l == 0 ? (r0_) : ((r0_) >> 11) * RPB + ((r0_) & 2047))
    int rowc = TOKC_ROW(gw);
    i32x4 ex = texp[rowc], ps = tpos[rowc]; f32x4 gt = tgate[rowc];
    RawF8 y0 = ld_raw_fp8(Y + (size_t)(tab[32 + ex[0]] * 256 + ps[0]) * DM, lane), y1 = ld_raw_fp8(Y + (size_t)(tab[32 + ex[1]] * 256 + ps[1]) * DM, lane);
    RawF8 y2 = ld_raw_fp8(Y + (size_t)(tab[32 + ex[2]] * 256 + ps[2]) * DM, lane), y3 = ld_raw_fp8(Y + (size_t)(tab[32 + ex[3]] * 256 + ps[3]) * DM, lane);
    RawBf xr = ld_raw_bf16(XB + (size_t)rowc * DM, lane);
    int r1 = gw + NGW < nrows ? gw + NGW : gw, rown = TOKC_ROW(r1);
    i32x4 exn = texp[rown], psn = tpos[rown]; f32x4 gtn = tgate[rown];
    for (int r0 = gw; r0 < nrows; r0 += NGW) {
        const int row = rowc;
        const int b = row / RPB, t = row % RPB, mr = t < SEQ ? b : 8; const float* mod = mods + ((size_t)l * 9 + mr) * 6144;
        const RawF8 c0 = y0, c1 = y1, c2 = y2, c3 = y3; const RawBf cx = xr; const f32x4 cg = gt;
        y0 = ld_raw_fp8(Y + (size_t)(tab[32 + exn[0]] * 256 + psn[0]) * DM, lane); y1 = ld_raw_fp8(Y + (size_t)(tab[32 + exn[1]] * 256 + psn[1]) * DM, lane);
        y2 = ld_raw_fp8(Y + (size_t)(tab[32 + exn[2]] * 256 + psn[2]) * DM, lane); y3 = ld_raw_fp8(Y + (size_t)(tab[32 + exn[3]] * 256 + psn[3]) * DM, lane);
        xr = ld_raw_bf16(XB + (size_t)rown * DM, lane);
        rowc = rown; gt = gtn;
        { const int r2 = r0 + 2 * NGW < nrows ? r0 + 2 * NGW : r0; rown = TOKC_ROW(r2); exn = texp[rown]; psn = tpos[rown]; gtn = tgate[rown]; }
        Row f;
        { const Row a0 = cvt_raw(c0), a1 = cvt_raw(c1), a2 = cvt_raw(c2), a3 = cvt_raw(c3);
#pragma unroll
          for (int j = 0; j < 4; ++j) f.v[j] = (a0.v[j] * cg[0] + a1.v[j] * cg[1]) + (a2.v[j] * cg[2] + a3.v[j] * cg[3]); }
        const float rs = row_rs(f);
        const Row x1 = cvt_raw(cx), G3 = ld_row_f32(gn + 3 * DM, lane), GT = ld_row_f32(mod + 5120, lane); Row x2;
#pragma unroll
        for (int j = 0; j < 4; ++j) x2.v[j] = x1.v[j] + GT.v[j] * (f.v[j] * rs * G3.v[j]);
        if (l == 0) {
            st_row_bf16(XB + (size_t)row * DM, lane, x2);
            const float* mod1 = mods + ((size_t)9 + mr) * 6144;
            const Row h = norm_mod(x2, row_rs(x2), a.in[6] + 4 * DM, mod1, mod1 + 1024, lane);
            st_row_bf16(H + (size_t)row * DM, lane, h);
        } else {
            st_row_f32(a.out + ((size_t)b * SEQ + t) * DM, lane, x2);
        }
    }
#undef TOKC_ROW
}
__device__ __forceinline__ void phase_dbg_out(const Args& a, unsigned char* ws, int from_x, int lane, int gw, int NGW) {
    const bf16* XB = (const bf16*)(ws + WS_XB);
    for (int r0 = gw; r0 < NB * SEQ; r0 += NGW) { const int row = (r0 >> 11) * RPB + (r0 & 2047);
        const Row x = from_x ? ld_row_f32(a.in[0] + (size_t)r0 * DM, lane) : ld_row_bf16(XB + (size_t)row * DM, lane); st_row_f32(a.out + (size_t)r0 * DM, lane, x); }
}

constexpr int LAST_PH = DBG_STAGE == 0 ? NPH - 1 : DBG_STAGE == 1 ? -1 : DBG_STAGE == 2 ? 6 : DBG_STAGE == 3 ? 9 : 14;
template <int l>
__device__ __forceinline__ void layer_phases(const Args& args, unsigned char* ws, LAS unsigned char* lds, unsigned char* lds_raw, const XcdBarrier& bar, int lo, int hi,
                                             int tid, int lane, int wave, int G, int bx, int vcu, int gw, int NGW, int gtid, int NGT) {
    constexpr bool ONE = (MK_N_LAUNCHES == 1);
#define IN(k) (lo <= (k) && (k) < hi)
#define SEAM(k) do { if (ONE && IN((k) + 1)) { xcd_barrier(bar); if (DBL_BAR) xcd_barrier(bar); } PROBE_STAMP(k); } while (0)
        constexpr int P = 2 + 8 * l;
        constexpr int nq = l == 0 ? NQA : NQB;
        const bool bgw_on = BGW && l == 0 && G == 256, is_worker = bgw_on && ((bx >> 3) & 7) == 7;
        const int Gw = bgw_on ? G - 32 : G, bxw = bgw_on ? bx - 8 * (bx >> 6) : bx, vcuw = bgw_on ? vcu - (vcu >> 3) : vcu, wrank = ((bx >> 6) << 3) | (bx & 7);
        const int wq2 = bgw_on ? WQ2 : 0, wq4 = bgw_on ? WQ4 : 0, wq5 = bgw_on ? WQ5 : 0;
        if (IN(P) && P <= LAST_PH) {
            pg8::Gemm g{(const pg8::bf16_t*)(ws + WS_H), (const pg8::bf16_t*)(ws + (l == 0 ? WS_WQA : WS_WQB)), T, nq, DM};
            pg8::StaticOrder S; S.init(T, nq, Gw, bxw);
            if (is_worker) { conv_range(args, ws, lds, 0, 0, 0, wq2, lane, wave, wrank * 8 + wave, 32 * 8, true); }
            else if constexpr (l == 0) { LAS float* rl = (LAS float*)(lds + 135168); for (int i = tid; i < 2048; i += 512) rl[i] = ((const float*)(ws + WS_ROPE))[i]; __syncthreads();
                pg8::EpiRopeA E{(pg8::bf16_t*)(ws + WS_QKV), rl, rl + 1024};
                for (int rep = 0; rep < NREP(P); ++rep) pg8::gemm_phase<pg8::EpiRopeA, pg8::StaticOrder, true, true, false>(lds, g, S, E); }
            else if constexpr (QKB_FUSE != 0) { pg8::EpiQkB E{(pg8::bf16_t*)(ws + WS_QKV), (const float*)(ws + WS_ROPE) + 2048, (const float*)(ws + WS_ROPE) + 4096, args.in[11], args.in[12], (LAS float*)(lds + 135168)};
                for (int rep = 0; rep < NREP(P); ++rep) pg8::gemm_phase<pg8::EpiQkB, pg8::StaticOrder, true, true, false>(lds, g, S, E); }
            else { pg8::EpiStore E{(pg8::bf16_t*)(ws + WS_QKV), nq, nullptr, 0, 1.0f};
                for (int rep = 0; rep < NREP(P); ++rep) pg8::gemm_phase<pg8::EpiStore, pg8::StaticOrder, true, true, false>(lds, g, S, E); }
            if (W1_LATE && l == 1 && CONV_B == 0) { int ni; const int ii = idle_index(432, G, bx, ni); if (ii >= 0) conv_range(args, ws, lds, 1, 0, 0, early_items(1, G), lane, wave, ii * 8 + wave, ni * 8); }
            SEAM(P);
        }
        if (IN(P + 1) && P + 1 <= LAST_PH) { if constexpr (l == 1 && QKB_FUSE == 0) { phase_qkfix_b(args, ws, gtid, NGT); SEAM(P + 1); } }
        if (IN(P + 2) && P + 2 <= LAST_PH) { for (int rep = 0; rep < NREP(P + 2); ++rep) { if (is_worker) conv_range(args, ws, lds, 0, 0, wq2, wq2 + wq4, lane, wave, wrank * 8 + wave, 32 * 8, true); else if (l == 0) phase_attn_a(args, ws, (char*)lds_raw, vcuw, Gw); else phase_attn_b(args, ws, (char*)lds_raw, vcu, G); __syncthreads(); } SEAM(P + 2); }
        if (IN(P + 3) && P + 3 <= LAST_PH) {
            pg8::Gemm g{(const pg8::bf16_t*)(ws + WS_AO), (const pg8::bf16_t*)(ws + (l == 0 ? WS_WOA : WS_WOB)), T, DM, DM};
            pg8::StaticOrder S; S.init(l == 0 ? T : NB * SEQ, DM, Gw, bxw, l);
            pg8::EpiStore E{(pg8::bf16_t*)(ws + WS_AP), DM, nullptr, 0, 1.0f};
            if (is_worker) conv_range(args, ws, lds, 0, 0, wq2 + wq4, wq2 + wq4 + wq5, lane, wave, wrank * 8 + wave, 32 * 8, true);
            else for (int rep = 0; rep < NREP(P + 3); ++rep) pg8::gemm_phase<pg8::EpiStore, pg8::StaticOrder, true, true, false>(lds, g, S, E);
            if (W1_LATE && l == 0 && CONV_A == 0 && !bgw_on) { int ni; const int ii = idle_index(288, G, bx, ni); if (ii >= 0) conv_range(args, ws, lds, 0, 0, 32 * 512 - early_items(0, G), 32 * 512, lane, wave, ii * 8 + wave, ni * 8); }
            SEAM(P + 3);
        }
        if (IN(P + 4) && P + 4 <= LAST_PH) {
            const int done = CONV_CNT(l) * NGW, d1 = done > 16384 ? (done - 16384 < 32768 ? (done - 16384) >> 1 : 16384) : 0, e1 = bgw_on ? wq2 + wq4 + wq5 : (CONV_CNT(l) ? 0 : early_items(l, G));
            const bool conv_first = TOKB_MIX && (vcu & 1);
            const bool rev = (l == 0 && CONV_A == 0 && !bgw_on); const int tlo = rev ? 0 : (d1 > e1 ? d1 : e1), thi = rev ? 32 * 512 - e1 : 32 * 512;
            const bool split = TOKB_MIX && (G & 1) == 0; const int tmid = split ? ((((tlo + thi) >> 1) + 511) & ~511) : thi,     hw = (vcu >> 1) * 8 + wave, hn = (G >> 1) * 8;
            if (W1_LATE && conv_first) { if (split) conv_range(args, ws, lds, l, 0, tmid, thi, lane, wave, hw, hn); else conv_range(args, ws, lds, l, 0, tlo, thi, lane, wave, gw, NGW); }
            phase_tok_b(args, ws, lds, l, tid, lane, wave, gw, NGW);
            if (W1_LATE && !conv_first) { if (split) conv_range(args, ws, lds, l, 0, tlo, tmid, lane, wave, hw, hn); else conv_range(args, ws, lds, l, 0, tlo, thi, lane, wave, gw, NGW); }
            SEAM(P + 4); }
        if (IN(P + 5) && P + 5 <= LAST_PH) {
            moe_tables(ws, lds, l, tid);
            pg8::Gemm g{(const pg8::bf16_t*)(ws + WS_H8), (const pg8::bf16_t*)(ws + WS_W1 + (size_t)l * NE * 2048 * DM), T, 2048, DM / 2};
            pg8::MoeOrder S{(const LAS int*)(lds + TAB_OFF), 8, G, vcu, (const int*)(ws + WS_LIST), CAP};
            pg8::EpiSwiglu8 E{ws + WS_ACT, args.in[17] + (size_t)l * NE * 2048, 1.0f / WSCALE};
#if defined(EPI_NULL) && EPI_NULL
            pg8::gemm_phase<pg8::EpiSwiglu8, pg8::MoeOrder, MOE_ALIGN, true, true, true>(lds, g, S, E);
            if (NREP(P + 5) == 2) { __syncthreads(); pg8::EpiNull EN{}; pg8::MoeOrder S2 = S; S2.same = (EPI_NULL == 2); pg8::gemm_phase<pg8::EpiNull, pg8::MoeOrder, MOE_ALIGN, true, true, true>(lds, g, S2, EN); }
#else
            for (int rep = 0; rep < NREP(P + 5); ++rep) pg8::gemm_phase<pg8::EpiSwiglu8, pg8::MoeOrder, MOE_ALIGN, true, true, true>(lds, g, S, E);
#endif
            if (W1_LATE) { const int done = CONV_CNT(l) * NGW, d2 = done < 16384 ? done >> 1 : 8192;
                const int ne = (((const LAS int*)(lds + TAB_OFF))[65] * 8) % G, half = d2 + ((32 * 256 - d2) >> 1);
                if (d2 < 32 * 256) { conv_range(args, ws, lds, l, 1, d2, half, lane, wave, gw, NGW);
                    if (ne == 0) conv_range(args, ws, lds, l, 1, half, 32 * 256, lane, wave, gw, NGW);
                    else if (vcu >= ne) conv_range(args, ws, lds, l, 1, half, 32 * 256, lane, wave, (vcu - ne) * 8 + wave, (G - ne) * 8); } }
            SEAM(P + 5);
        }
        if (IN(P + 6) && P + 6 <= LAST_PH) {
            if (!ONE || !IN(P + 5)) moe_tables(ws, lds, l, tid);
            pg8::Gemm g{(const pg8::bf16_t*)(ws + WS_ACT), (const pg8::bf16_t*)(ws + WS_W2 + (size_t)l * NE * DM * DM), T, DM, DM / 2};
            pg8::MoeOrder S{(const LAS int*)(lds + TAB_OFF), 4, G, vcu, (const int*)(ws + WS_LIST), CAP};
            pg8::EpiStore8 E{ws + WS_Y, DM, args.in[19] + (size_t)l * NE * DM, DM, 1.0f / WSCALE};
            for (int rep = 0; rep < NREP(P + 6); ++rep) pg8::gemm_phase<pg8::EpiStore8, pg8::MoeOrder, MOE_ALIGN, true, false, true>(lds, g, S, E);
            SEAM(P + 6);
        }
        if (IN(P + 7) && P + 7 <= LAST_PH) { if (!ONE || !IN(P + 5)) moe_tables(ws, lds, l, tid); phase_tok_c(args, ws, lds, l, lane, gw, NGW); if (l == 1 && NREP(P + 7) == 2) phase_tok_c(args, ws, lds, l, lane, gw, NGW); if (l == 0) SEAM(P + 7); }
    #undef IN
#undef SEAM
}

__global__ void __launch_bounds__(512, 2) fwd(Args args) {
    extern __shared__ __attribute__((aligned(16))) unsigned char lds_raw[];
    LAS unsigned char* lds = (LAS unsigned char*)lds_raw;
    const int tid = threadIdx.x, lane = tid & 63, wave = __builtin_amdgcn_readfirstlane(tid >> 6);
    const int G = gridDim.x, bx = blockIdx.x, vcu = (G % 8 == 0) ? (bx % 8) * (G / 8) + bx / 8 : bx;
    const int gw = vcu * 8 + wave, NGW = G * 8, gtid = vcu * 512 + tid, NGT = G * 512;
    unsigned char* ws = args.ws;
    volatile LAS unsigned* MISC = (volatile LAS unsigned*)(lds + MISC_OFF);
    if (tid < 64) MISC[tid] = 0u;
    __syncthreads();
    constexpr bool ONE = (MK_N_LAUNCHES == 1);
    XcdBarrier bar; bar.bar = (unsigned*)(ws + WS_CTL) + CW_BAR; bar.x = 0; bar.st = nullptr;
    if (ONE) bar = xcd_barrier_post((unsigned*)(ws + WS_CTL) + CW_BAR, MISC + 8);
    const int lo = args.ph_lo, hi = args.ph_hi;
    if (PROBE_ON && bx == 0 && tid == 0) { volatile LAS unsigned* pm_ = (volatile LAS unsigned*)(lds + MISC_OFF) + 16; pm_[0] = (unsigned)__builtin_amdgcn_s_memrealtime(); pm_[1] = 0u; }
#define IN(k) (lo <= (k) && (k) < hi)
#define SEAM(k) do { if (ONE && IN((k) + 1)) { xcd_barrier(bar); if (DBL_BAR) xcd_barrier(bar); } PROBE_STAMP(k); } while (0)

    if (IN(0) && 0 <= LAST_PH) { for (int rep = 0; rep < NREP(0); ++rep) { phase_pro_a(args, ws, lds, tid, lane, wave, vcu, G); __syncthreads(); } SEAM(0); }
#if defined(STREAM_TEST) && STREAM_TEST
    { unsigned t0_ = 0; if (bx == 0 && tid == 0) t0_ = (unsigned)__builtin_amdgcn_s_memrealtime();
      const size_t n4a = (size_t)2 * 32 * 1024 * 2048 / 4, n4b = (size_t)2 * 32 * 1024 * 1024 / 4;
      unsigned* dst = (unsigned*)(ws + (size_t)1100 * MiB);
      for (size_t i = (size_t)gtid; i < n4a + n4b; i += (size_t)NGT) { const f32x4 v = i < n4a ? ((const f32x4*)args.in[16])[i] : ((const f32x4*)args.in[18])[i - n4a]; dst[i] = pack4_fp8(v.x * 32.f, v.y * 32.f, v.z * 32.f, v.w * 32.f); }
      xcd_barrier(bar);
      if (bx == 0 && tid == 0) { volatile LAS unsigned* pm_ = (volatile LAS unsigned*)(lds + MISC_OFF) + 16; pm_[2] = (unsigned)__builtin_amdgcn_s_memrealtime() - t0_; } }
#endif
    if (IN(1) && 1 <= LAST_PH) { for (int rep = 0; rep < NREP(1); ++rep) phase_pro_b(args, ws, lane, gw, NGW); SEAM(1); }
    layer_phases<0>(args, ws, lds, lds_raw, bar, lo, hi, tid, lane, wave, G, bx, vcu, gw, NGW, gtid, NGT);
    layer_phases<1>(args, ws, lds, lds_raw, bar, lo, hi, tid, lane, wave, G, bx, vcu, gw, NGW, gtid, NGT);
#if defined(STREAM_TEST) && STREAM_TEST
    { if (bx == 0 && tid == 0) { volatile LAS unsigned* pm_ = (volatile LAS unsigned*)(lds + MISC_OFF) + 16; const unsigned t0_ = (unsigned)__builtin_amdgcn_s_memrealtime(), d_ = pm_[2];
            while ((unsigned)__builtin_amdgcn_s_memrealtime() - t0_ < d_) __builtin_amdgcn_s_sleep(8); } __syncthreads(); }
#endif
    if (PROBE_ON) {
        PROBE_STAMP(NPH - 1);
        if (bx == 0 && tid == 0) { volatile LAS unsigned* pm_ = (volatile LAS unsigned*)(lds + MISC_OFF) + 16; const unsigned t0_ = (unsigned)__builtin_amdgcn_s_memrealtime(), d_ = pm_[1];
            while ((unsigned)__builtin_amdgcn_s_memrealtime() - t0_ < d_) __builtin_amdgcn_s_sleep(8); }
        __syncthreads();
    }
    if (DBG_STAGE != 0 && IN(NPH - 1)) {
        if (ONE) xcd_barrier(bar);
        phase_dbg_out(args, ws, DBG_STAGE == 1, lane, gw, NGW);
    }
#undef IN
#undef SEAM
}

extern "C" void kernel_launch(void* const* d_in, const int* in_sizes, int n_in, void* d_out, int out_size, void* d_ws, size_t ws_size, hipStream_t stream) {
    static int grid = 0;
    if (grid == 0) {
        if (n_in != NIN || in_sizes[0] != NB * SEQ * DM || out_size != NB * SEQ * DM || ws_size < WS_END) {
            fprintf(stderr, "kernel_launch: built for %d inputs, x/out of %d floats, >= %zu bytes of workspace; got n_in %d, in0 %d, out %d, ws %zu; nothing launched\n", NIN, NB * SEQ * DM, (size_t)WS_END, n_in, n_in > 0 ? in_sizes[0] : -1, out_size, ws_size); grid = -1; return; }
        int dev = 0, cus = 0, per_cu = 0;
        if (hipGetDevice(&dev) != hipSuccess || hipDeviceGetAttribute(&cus, hipDeviceAttributeMultiprocessorCount, dev) != hipSuccess) { fprintf(stderr, "kernel_launch: hipGetDevice / hipDeviceGetAttribute failed\n"); grid = -1; return; }
        if (hipFuncSetAttribute((const void*)fwd, hipFuncAttributeMaxDynamicSharedMemorySize, LDS_BYTES) != hipSuccess) { fprintf(stderr, "kernel_launch: hipFuncSetAttribute failed\n"); grid = -1; return; }
        if (hipOccupancyMaxActiveBlocksPerMultiprocessor(&per_cu, (const void*)fwd, 512, LDS_BYTES) != hipSuccess || per_cu < 1)
            fprintf(stderr, "kernel_launch: note: the occupancy query reports %d workgroups per CU\n", per_cu);
        (void)hipGetLastError();
        grid = cus;
    }
    if (grid < 0) return;
    if (hipMemsetAsync((char*)d_ws + WS_CTL, 0, CTL_ZERO_BYTES, stream) != hipSuccess) { fprintf(stderr, "kernel_launch: hipMemsetAsync failed\n"); return; }
    Args a{};
    for (int i = 0; i < NIN; ++i) a.in[i] = (const float*)d_in[i];
    a.out = (float*)d_out; a.ws = (unsigned char*)d_ws;
    for (int li = 0; li < MK_N_LAUNCHES; ++li) {
        a.ph_lo = (MK_N_LAUNCHES == 1) ? 0 : li; a.ph_hi = (MK_N_LAUNCHES == 1) ? NPH : li + 1;
        hipLaunchKernelGGL(fwd, dim3(grid), dim3(512), LDS_BYTES, stream, a);
        const hipError_t le = hipPeekAtLastError();
        if (le != hipSuccess) { fprintf(stderr, "kernel_launch: launch %d failed: %s\n", li, hipGetErrorName(le)); break; }
    }
}
```
